# Optimizing an MI355X kernel written in HIP

```python
import jax, jax.numpy as jnp
from jax import lax
import numpy as np

D_MODEL = 2048
BATCH = 1
SEQ = 8192
DEPTH = 4

GRID_W = 64
CTX_LEN = 256
N_MIXERS = 2
HEAD_DIM = 128
N_HEADS = D_MODEL // HEAD_DIM
N_KV_HEADS = N_HEADS // 4
GROUP = N_HEADS // N_KV_HEADS
D_Q = N_HEADS * HEAD_DIM
D_KV = N_KV_HEADS * HEAD_DIM
WINDOW = 128
BLOCK = 128
ROPE_PAIRS = HEAD_DIM // 4
ROPE_BASE = 10000.0
CONV_W = 3
D_FF = ((8 * D_MODEL // 3 + 255) // 256) * 256
N_ATTN_LAYERS = (DEPTH + N_MIXERS - 1) // N_MIXERS
N_CONV_LAYERS = DEPTH // N_MIXERS
EPS = 1e-6
NEG_INF = -1e30

kernel_name = "hybrid_swa_shortconv_dit_prefix"


def rms_norm(x):
    xf = x.astype(jnp.float32)
    return (xf * lax.rsqrt(jnp.mean(xf * xf, axis=-1, keepdims=True) + EPS)).astype(x.dtype)


def modulate(x, shift, scale):
    return rms_norm(x) * (1 + scale) + shift


def adaln(cond_act, w, b):
    return jnp.split(cond_act @ w + b, 6, axis=-1)


def dwconv3(x, w):
    xp = jnp.pad(x, ((0, 0), (1, 1), (0, 0)))
    return xp[:, :-2] * w[0] + xp[:, 1:-1] * w[1] + xp[:, 2:] * w[2]


def rope_tables(n):
    rows = n // GRID_W
    row = jnp.repeat(jnp.arange(rows), GRID_W).astype(jnp.float32)
    col = jnp.tile(jnp.arange(GRID_W), rows).astype(jnp.float32)
    inv = ROPE_BASE ** (-jnp.arange(ROPE_PAIRS, dtype=jnp.float32) / ROPE_PAIRS)
    ang = jnp.stack([row[:, None] * inv, col[:, None] * inv], axis=1)
    ang = jnp.broadcast_to(ang[:, :, None, :], (n, 2, 2, ROPE_PAIRS)).reshape(n, HEAD_DIM)
    return jnp.cos(ang), jnp.sin(ang)


def apply_rope(x, cos, sin):
    xf = x.astype(jnp.float32)
    xr = xf.reshape(*x.shape[:-1], 2, 2, ROPE_PAIRS)
    rot = jnp.stack([-xr[..., 1, :], xr[..., 0, :]], axis=-2).reshape(x.shape)
    return (xf * cos[:, None, :] + rot * sin[:, None, :]).astype(x.dtype)


def band_mask(n):
    nb = n // BLOCK
    qi = jnp.arange(BLOCK)[None, :, None]
    kk = jnp.arange(3 * BLOCK)[None, None, :]
    blk = jnp.arange(nb)[:, None, None]
    kpos = blk * BLOCK - BLOCK + kk
    rel = qi - kk + BLOCK
    return (jnp.abs(rel) <= WINDOW) & (kpos >= 0) & (kpos < n)


def sink_softmax(s, sink):
    m = jnp.maximum(jnp.max(s, axis=-1, keepdims=True), sink)
    e = jnp.exp(s - m)
    return e / (jnp.sum(e, axis=-1, keepdims=True) + jnp.exp(sink - m))


def project_q(h, w_q, gain):
    q = (h @ w_q).reshape(*h.shape[:-1], N_HEADS, HEAD_DIM)
    return rms_norm(q) * gain


def project_kv(h, w_kv, gain):
    k, v = jnp.split(h @ w_kv, 2, axis=-1)
    k = rms_norm(k.reshape(*h.shape[:-1], N_KV_HEADS, HEAD_DIM)) * gain
    v = v.reshape(*h.shape[:-1], N_KV_HEADS, HEAD_DIM)
    return k, v


def attention_mixer(h_x, h_c, w_qkv, w_o, q_gain, k_gain, sink, cos, sin, mask, need_ctx):
    b, n, _ = h_x.shape
    nb = n // BLOCK
    scale = HEAD_DIM ** -0.5
    w_q, w_kv = w_qkv[:, :D_Q], w_qkv[:, D_Q:]
    q = apply_rope(project_q(h_x, w_q, q_gain), cos, sin)
    k, v = project_kv(h_x, w_kv, k_gain)
    k = apply_rope(k, cos, sin)
    kc, vc = project_kv(h_c, w_kv, k_gain)
    sink_f = sink.astype(jnp.float32).reshape(N_KV_HEADS, GROUP)

    qb = q.reshape(b, nb, BLOCK, N_KV_HEADS, GROUP, HEAD_DIM)
    pad = ((0, 0), (BLOCK, BLOCK), (0, 0), (0, 0))
    kp = jnp.pad(k, pad).reshape(b, nb + 2, BLOCK, N_KV_HEADS, HEAD_DIM)
    vp = jnp.pad(v, pad).reshape(b, nb + 2, BLOCK, N_KV_HEADS, HEAD_DIM)
    kb = jnp.concatenate([kp[:, :-2], kp[:, 1:-1], kp[:, 2:]], axis=2)
    vb = jnp.concatenate([vp[:, :-2], vp[:, 1:-1], vp[:, 2:]], axis=2)
    s_loc = jnp.einsum('bnqhgd,bnkhd->bhgnqk', qb, kb).astype(jnp.float32) * scale
    s_loc = jnp.where(mask, s_loc, NEG_INF)
    s_ctx = jnp.einsum('bnqhgd,bkhd->bhgnqk', qb, kc).astype(jnp.float32) * scale
    p = sink_softmax(jnp.concatenate([s_loc, s_ctx], axis=-1),
                     sink_f[None, :, :, None, None, None]).astype(v.dtype)
    o = (jnp.einsum('bhgnqk,bnkhd->bnqhgd', p[..., :3 * BLOCK], vb)
         + jnp.einsum('bhgnqk,bkhd->bnqhgd', p[..., 3 * BLOCK:], vc))
    out_x = o.reshape(b, n, D_Q) @ w_o

    out_c = None
    if need_ctx:
        l = h_c.shape[1]
        qc = project_q(h_c, w_q, q_gain).reshape(b, l, N_KV_HEADS, GROUP, HEAD_DIM)
        s_c = jnp.einsum('bqhgd,bkhd->bhgqk', qc, kc).astype(jnp.float32) * scale
        p_c = sink_softmax(s_c, sink_f[None, :, :, None, None]).astype(vc.dtype)
        oc = jnp.einsum('bhgqk,bkhd->bqhgd', p_c, vc)
        out_c = oc.reshape(b, l, D_Q) @ w_o
    return out_x, out_c


def short_conv_mixer(h, w_in, conv_w, w_out):
    gate_b, gate_c, val = jnp.split(h @ w_in, 3, axis=-1)
    return (gate_b * dwconv3(gate_c * val, conv_w)) @ w_out


def conv_ffn(h, w_up, conv_w, conv_b, w_down):
    gate, val = jnp.split(h @ w_up, 2, axis=-1)
    gate = dwconv3(gate, conv_w) + conv_b
    return (jax.nn.silu(gate) * val) @ w_down


def setup_inputs(seed: int = 0) -> dict:
    key = jax.random.key(seed)
    ks = jax.random.split(key, 20)

    def nrm(k, shape, scale):
        return jax.random.normal(k, shape, jnp.float32) * scale

    d = D_MODEL
    return {
        "x": nrm(ks[0], (BATCH, SEQ, d), 1.0),
        "c": nrm(ks[1], (BATCH, d), 1.0),
        "ctx": nrm(ks[2], (BATCH, CTX_LEN, d), 1.0),
        "c_ctx": nrm(ks[3], (d,), 1.0),
        "w_ada": nrm(ks[4], (DEPTH, d, 6 * d), 0.5 * d ** -0.5),
        "b_ada": nrm(ks[5], (DEPTH, 6 * d), 0.02),
        "attn_w_qkv": nrm(ks[6], (N_ATTN_LAYERS, d, D_Q + 2 * D_KV), d ** -0.5),
        "attn_w_o": nrm(ks[7], (N_ATTN_LAYERS, D_Q, d), D_Q ** -0.5),
        "attn_q_gain": 1.0 + nrm(ks[8], (N_ATTN_LAYERS, HEAD_DIM), 0.1),
        "attn_k_gain": 1.0 + nrm(ks[9], (N_ATTN_LAYERS, HEAD_DIM), 0.1),
        "attn_sink": nrm(ks[10], (N_ATTN_LAYERS, N_HEADS), 0.5),
        "sc_w_in": nrm(ks[11], (N_CONV_LAYERS, d, 3 * d), d ** -0.5),
        "sc_conv": nrm(ks[12], (N_CONV_LAYERS, CONV_W, d), CONV_W ** -0.5),
        "sc_w_out": nrm(ks[13], (N_CONV_LAYERS, d, d), d ** -0.5),
        "ffn_w_up": nrm(ks[14], (DEPTH, d, 2 * D_FF), d ** -0.5),
        "ffn_conv": nrm(ks[15], (DEPTH, CONV_W, D_FF), CONV_W ** -0.5),
        "ffn_conv_b": nrm(ks[16], (DEPTH, D_FF), 0.02),
        "ffn_w_down": nrm(ks[17], (DEPTH, D_FF, d), D_FF ** -0.5),
    }


def reference(x, c, ctx, c_ctx, w_ada, b_ada, attn_w_qkv, attn_w_o, attn_q_gain, attn_k_gain,
              attn_sink, sc_w_in, sc_conv, sc_w_out, ffn_w_up, ffn_conv, ffn_conv_b, ffn_w_down):
    n = x.shape[1]
    cos, sin = rope_tables(n)
    mask = band_mask(n)
    silu_c = jax.nn.silu(c)
    silu_cc = jax.nn.silu(c_ctx)

    for l in range(DEPTH):
        is_attn = (l % N_MIXERS) == 0
        j = l // N_MIXERS
        need_ctx = l < DEPTH - 1
        sh_m, sc_m, g_m, sh_f, sc_f, g_f = [t[:, None, :] for t in adaln(silu_c, w_ada[l], b_ada[l])]
        h_x = modulate(x, sh_m, sc_m)
        y_c = None
        if need_ctx or is_attn:
            csh_m, csc_m, cg_m, csh_f, csc_f, cg_f = adaln(silu_cc, w_ada[l], b_ada[l])
            h_c = modulate(ctx, csh_m, csc_m)
        if is_attn:
            y_x, y_c = attention_mixer(h_x, h_c, attn_w_qkv[j], attn_w_o[j], attn_q_gain[j],
                                       attn_k_gain[j], attn_sink[j], cos, sin, mask, need_ctx)
        else:
            y_x = short_conv_mixer(h_x, sc_w_in[j], sc_conv[j], sc_w_out[j])
            if need_ctx:
                y_c = short_conv_mixer(h_c, sc_w_in[j], sc_conv[j], sc_w_out[j])
        x = x + g_m * y_x
        x = x + g_f * conv_ffn(modulate(x, sh_f, sc_f), ffn_w_up[l], ffn_conv[l], ffn_conv_b[l], ffn_w_down[l])
        if need_ctx:
            ctx = ctx + cg_m * y_c
            ctx = ctx + cg_f * conv_ffn(modulate(ctx, csh_f, csc_f), ffn_w_up[l], ffn_conv[l],
                                        ffn_conv_b[l], ffn_w_down[l])
    return x
```

```cpp
#include <hip/hip_runtime.h>
#include <hip/hip_bf16.h>
#include <cstdio>
#include <cstdint>

__device__ __forceinline__ int hw_lane() { int l; asm volatile("v_mbcnt_lo_u32_b32 %0, -1, 0\n\tv_mbcnt_hi_u32_b32 %0, -1, %0" : "=v"(l)); return l; }

namespace pg8 {
#define PG8_LAS __attribute__((address_space(3)))
typedef unsigned short bf16_t;
typedef short bf16x8 __attribute__((ext_vector_type(8)));
typedef float f32x4 __attribute__((ext_vector_type(4)));
typedef unsigned u32x4 __attribute__((ext_vector_type(4)));
constexpr int BM = 256, BK = 64, HALF = 128, HTB = HALF * BK * 2  , STAGE_BYTES = 8 * HTB, NXCD = 8, WGM = 8;

__host__ __device__ __forceinline__ int lds_byte(int r, int c) { const int st = (r >> 4) * 2 + (c >> 5), rr = r & 15, cc = c & 31, ob = rr * 64 + cc * 2; return st * 1024 + (ob ^ (((ob >> 9) & 1) << 5)); }
__host__ __device__ __forceinline__ void stage_rc(int b, int& R, int& C) { const int st = b / 1024, sb = b % 1024, swz = sb ^ (((sb >> 9) & 1) << 5); R = (st >> 1) * 16 + swz / 64; C = (st & 1) * 32 + (swz % 64) / 2; }
__host__ __device__ __forceinline__ int perm32(int rho) { const int n = rho >> 4, i = rho & 15; return 8 * (i >> 2) + 4 * n + (i & 3); }

struct Unit { int pm, pn; };
struct Gemm { const bf16_t* A; const bf16_t* Bt; int M, N, K;
    int a_row0, a_rstride, ctx_pm, ctx_row;
    __host__ __device__ __forceinline__ size_t arow(int pm) const { return pm >= ctx_pm ? (size_t)ctx_row : (size_t)(a_row0 + pm * a_rstride); } };

struct StaticOrder {
    int nM, nN, nwg, G, c;
    __host__ __device__ void init(int M, int N, int G_, int c_) { nM = M / BM; nN = N / BM; nwg = nM * nN; G = G_; c = c_; }
    __host__ __device__ bool next(int i, Unit& u) const {
        const long L = (long)i * G + c; if (L >= nwg) return false;
        int wgid = (int)L; { const int q = nwg / NXCD, r = nwg % NXCD, xcd = wgid % NXCD, off = wgid / NXCD; wgid = (xcd < r ? xcd * (q + 1) : r * (q + 1) + (xcd - r) * q) + off; }
        const int nig = WGM * nN, gid = wgid / nig, fm = gid * WGM, gsz = (nM - fm) < WGM ? (nM - fm) : WGM;
        u.pm = fm + ((wgid % nig) % gsz); u.pn = (wgid % nig) / gsz; return true;
    }
    __device__ __forceinline__ void a_ready(const Unit&) const {}
    __device__ __forceinline__ void done(const Unit&) const {}
};

__device__ __forceinline__ unsigned cvt_pk_bf16(float lo, float hi) { unsigned r; asm volatile("v_cvt_pk_bf16_f32 %0, %1, %2" : "=v"(r) : "v"(lo), "v"(hi)); return r; }

template <int CTRL> __device__ __forceinline__ float dpp_mov(float v) { return __int_as_float(__builtin_amdgcn_mov_dpp(__float_as_int(v), CTRL, 0xF, 0xF, true)); }
__device__ __forceinline__ float fq_sum(float v) {
    v += __int_as_float(__builtin_amdgcn_ds_swizzle(__float_as_int(v), 0x401F));
    const auto rr = __builtin_amdgcn_permlane32_swap(__float_as_uint(v), __float_as_uint(v), false, false);
    return __uint_as_float(rr[0]) + __uint_as_float(rr[1]);
}
__device__ __forceinline__ float ld_acc(const float* p) { return __uint_as_float(__hip_atomic_load((const unsigned*)p, __ATOMIC_RELAXED, __HIP_MEMORY_SCOPE_AGENT)); }
__device__ __forceinline__ f32x4 ld_bias4(const float* b, int nb, int stream, int col) { const float* p = b + (size_t)stream * nb + col; const size_t q = (size_t)2 * nb;
    return (*(const f32x4*)p + *(const f32x4*)(p + q)) + (*(const f32x4*)(p + 2 * q) + *(const f32x4*)(p + 3 * q)); }
struct EpiBf16 {
    static constexpr bool PERM = true, AFTER_DRAIN = false;
    bf16_t* O; int ldc; const float* rowss; const float* bias; int nb; int pm_ctx; float inv_k, eps;
    __device__ __forceinline__ void operator()(f32x4 (&acc)[2][2][4][2], const Unit& u, int wr, int wc, int fr, int fq) const {
        const int row0 = u.pm * BM + wr * 64 + fr, col0 = u.pn * BM + wc * 32 + 8 * fq;
        const int stream = (u.pm >= pm_ctx) ? 1 : 0;
        float rs[8];
#pragma unroll
        for (int i = 0; i < 8; ++i) rs[i] = ld_acc(rowss + row0 + (i >> 2) * HALF + (i & 3) * 16);
        f32x4 bv[2][2];
#pragma unroll
        for (int bj = 0; bj < 2; ++bj)
#pragma unroll
            for (int n = 0; n < 2; ++n) bv[bj][n] = (f32x4){0.f, 0.f, 0.f, 0.f};
        { f32x4 bp[4][2][2];
#pragma unroll
          for (int q = 0; q < 4; ++q)
#pragma unroll
            for (int bj = 0; bj < 2; ++bj)
#pragma unroll
                for (int n = 0; n < 2; ++n) bp[q][bj][n] = *(const f32x4*)(bias + (size_t)(2 * q + stream) * nb + col0 + bj * HALF + 4 * n);
          asm volatile("" ::: "memory");
#pragma unroll
          for (int bj = 0; bj < 2; ++bj)
#pragma unroll
            for (int n = 0; n < 2; ++n) bv[bj][n] = (bp[0][bj][n] + bp[1][bj][n]) + (bp[2][bj][n] + bp[3][bj][n]); }
#pragma unroll
        for (int ai = 0; ai < 2; ++ai)
#pragma unroll
            for (int m = 0; m < 4; ++m) { const int row = row0 + ai * HALF + m * 16; const float r = __builtin_amdgcn_rsqf(rs[ai * 4 + m] * inv_k + eps);
                bf16_t* rowp = O + (size_t)row * ldc + col0;
#pragma unroll
                for (int bj = 0; bj < 2; ++bj) { const f32x4 v0 = acc[ai][bj][m][0] * r + bv[bj][0], v1 = acc[ai][bj][m][1] * r + bv[bj][1];
                    u32x4 w; w.x = cvt_pk_bf16(v0[0], v0[1]); w.y = cvt_pk_bf16(v0[2], v0[3]); w.z = cvt_pk_bf16(v1[0], v1[1]); w.w = cvt_pk_bf16(v1[2], v1[3]);
                    *(u32x4*)(rowp + bj * HALF) = w; } }
    }
};
struct EpiResid {
    static constexpr bool PERM = true, AFTER_DRAIN = false;
    const float* X; float* Y; int ldc; const float* gate; bf16_t* HNo; const float* scn; float* rowss; int hn_row0;
    __device__ __forceinline__ void operator()(f32x4 (&acc)[2][2][4][2], const Unit& u, int wr, int wc, int fr, int fq) const {
        const int row0 = u.pm * BM + wr * 64 + fr, col0 = u.pn * BM + wc * 32 + 8 * fq;
        f32x4 gv[2][2], sv[2][2]; float ssq[8];
#pragma unroll
        for (int bj = 0; bj < 2; ++bj)
#pragma unroll
            for (int n = 0; n < 2; ++n) { gv[bj][n] = *(const f32x4*)(gate + col0 + bj * HALF + n * 4); sv[bj][n] = *(const f32x4*)(scn + col0 + bj * HALF + n * 4) + 1.f; }
#pragma unroll
        for (int ai = 0; ai < 2; ++ai)
#pragma unroll
            for (int mp = 0; mp < 2; ++mp) {
                f32x4 xv[2][2][2];
#pragma unroll
                for (int mm = 0; mm < 2; ++mm)
#pragma unroll
                    for (int bj = 0; bj < 2; ++bj)
#pragma unroll
                        for (int n = 0; n < 2; ++n) xv[mm][bj][n] = *(const f32x4*)(X + (size_t)(row0 + ai * HALF + (2 * mp + mm) * 16) * ldc + col0 + bj * HALF + n * 4);
                asm volatile("" ::: "memory");
#pragma unroll
                for (int mm = 0; mm < 2; ++mm) { const int m = 2 * mp + mm; const int row = row0 + ai * HALF + m * 16; const size_t off = (size_t)row * ldc + col0; float ss = 0.f;
#pragma unroll
                    for (int bj = 0; bj < 2; ++bj)
#pragma unroll
                        for (int n = 0; n < 2; ++n) { const f32x4 y = xv[mm][bj][n] + gv[bj][n] * acc[ai][bj][m][n];
                            *(f32x4*)(Y + off + bj * HALF + n * 4) = y;
                            if (HNo) { ss += (y[0] * y[0] + y[1] * y[1]) + (y[2] * y[2] + y[3] * y[3]); const f32x4 a = y * sv[bj][n];
                                typedef unsigned u32x2v __attribute__((ext_vector_type(2))); u32x2v w; w.x = cvt_pk_bf16(a[0], a[1]); w.y = cvt_pk_bf16(a[2], a[3]);
                                *(u32x2v*)(HNo + (size_t)(hn_row0 + row) * ldc + col0 + bj * HALF + n * 4) = w; } }
                    ssq[ai * 4 + m] = HNo ? fq_sum(ss) : 0.f; }
                asm volatile("" ::: "memory");
            }
        if (HNo && fq == 0) {
#pragma unroll
            for (int i = 0; i < 8; ++i) unsafeAtomicAdd(rowss + row0 + (i >> 2) * HALF + (i & 3) * 16, ssq[i]);
        }
    }
};

struct EpiGlu {
    static constexpr bool PERM = true, AFTER_DRAIN = false;
    bf16_t* U; int ldu; const float* cw; const float* cb; int dff; PG8_LAS f32x4* xch; int ctx_pm, seq;
    const float* rowss; const float* bias; int nb; float inv_k, eps;
    static __device__ __forceinline__ int xi(int ci, int which, int wc, int n, int fq) { return (((ci * 2 + which) * 4 + wc) * 2 + n) * 4 + fq; }
    __device__ __forceinline__ void operator()(f32x4 (&acc)[2][2][4][2], const Unit& u, int wr, int wc, int fr_, int fq_) const {
        int t_ = hw_lane(); asm volatile("" : "+v"(t_)); const int fr = t_ & 15, fq = (t_ >> 4) & 3; (void)fr_; (void)fq_;
        const int ch0 = u.pn * 128 + wc * 32 + 8 * fq;
        const bool is_ctx = u.pm >= ctx_pm;
        { const int stream = is_ctx ? 1 : 0; f32x4 bg[2], bv[2];
#pragma unroll
            for (int n = 0; n < 2; ++n) { bg[n] = ld_bias4(bias, nb, stream, ch0 + 4 * n); bv[n] = ld_bias4(bias, nb, stream, dff + ch0 + 4 * n); }
            float rs[8];
#pragma unroll
            for (int i = 0; i < 8; ++i) { const int R = 128 * (i >> 2) + 64 * wr + 16 * (i & 3) + fr; const int trow = is_ctx ? seq + R : 254 * u.pm - 1 + R;
                rs[i] = ld_acc(rowss + (is_ctx ? trow : (trow < 0 ? 0 : (trow >= seq ? seq - 1 : trow)))); }
#pragma unroll
            for (int ai = 0; ai < 2; ++ai)
#pragma unroll
                for (int m = 0; m < 4; ++m) { const int R = 128 * ai + 64 * wr + 16 * m + fr; const int trow = is_ctx ? seq + R : 254 * u.pm - 1 + R;
                    const bool valid = is_ctx || (trow >= 0 && trow < seq);
                    const float r = valid ? __builtin_amdgcn_rsqf(rs[ai * 4 + m] * inv_k + eps) : 0.f;
#pragma unroll
                    for (int n = 0; n < 2; ++n) { const f32x4 g = acc[ai][0][m][n] * r + bg[n]; acc[ai][0][m][n] = valid ? g : (f32x4){0.f, 0.f, 0.f, 0.f}; acc[ai][1][m][n] = acc[ai][1][m][n] * r + bv[n]; } } }
#pragma unroll
        for (int ai = 0; ai < 2; ++ai) { const int ci = 2 * ai + wr;
            if (fr == 0) {
#pragma unroll
                for (int n = 0; n < 2; ++n) xch[xi(ci, 0, wc, n, fq)] = acc[ai][0][0][n]; }
            if (fr == 15) {
#pragma unroll
                for (int n = 0; n < 2; ++n) xch[xi(ci, 1, wc, n, fq)] = acc[ai][0][3][n]; } }
        asm volatile("s_waitcnt lgkmcnt(0)" ::: "memory"); __builtin_amdgcn_s_barrier(); asm volatile("" ::: "memory");
        f32x4 w0[2], w1[2], w2[2], bb[2];
#pragma unroll
        for (int n = 0; n < 2; ++n) { w0[n] = *(const f32x4*)(cw + ch0 + 4 * n); w1[n] = *(const f32x4*)(cw + dff + ch0 + 4 * n); w2[n] = *(const f32x4*)(cw + 2 * dff + ch0 + 4 * n); bb[n] = *(const f32x4*)(cb + ch0 + 4 * n); }
        const bool l15 = fr == 15, l0 = fr == 0;
#pragma unroll
        for (int ai = 0; ai < 2; ++ai) { const int ci = 2 * ai + wr;
            f32x4 up[2], dn[2];
#pragma unroll
            for (int n = 0; n < 2; ++n) { up[n] = (f32x4){0.f, 0.f, 0.f, 0.f}; dn[n] = (f32x4){0.f, 0.f, 0.f, 0.f};
                if (ci > 0) up[n] = xch[xi(ci - 1, 1, wc, n, fq)];
                if (ci < 3) dn[n] = xch[xi(ci + 1, 0, wc, n, fq)]; }
#pragma unroll
            for (int m = 0; m < 4; ++m) {
                const int R = 128 * ai + 64 * wr + 16 * m + fr;
                float o[8];
#pragma unroll
                for (int n = 0; n < 2; ++n)
#pragma unroll
                    for (int e = 0; e < 4; ++e) {
                        const float x = acc[ai][0][m][n][e];
                        const float xm1 = m > 0 ? acc[ai][0][m > 0 ? m - 1 : 0][n][e] : up[n][e];
                        const float xp1 = m < 3 ? acc[ai][0][m < 3 ? m + 1 : 3][n][e] : dn[n][e];
                        const float gu = dpp_mov<0x121>(l15 ? xm1 : x);
                        const float gd = dpp_mov<0x12F>(l0 ? xp1 : x);
                        const float t = w0[n][e] * gu + w1[n][e] * x + w2[n][e] * gd + bb[n][e];
                        o[4 * n + e] = t * __builtin_amdgcn_rcpf(1.f + __expf(-t)) * acc[ai][1][m][n][e];
                    }
                u32x4 w; w.x = cvt_pk_bf16(o[0], o[1]); w.y = cvt_pk_bf16(o[2], o[3]); w.z = cvt_pk_bf16(o[4], o[5]); w.w = cvt_pk_bf16(o[6], o[7]);
                int grow; bool ok;
                if (is_ctx) { grow = seq + R; ok = true; } else { grow = 254 * u.pm - 1 + R; ok = (R >= 1) && (R <= 254) && (grow < seq); }
                if (ok) *(u32x4*)(U + (size_t)grow * ldu + ch0) = w;
            }
        }
    }
};
template <class Epi, class Sched, bool ALIGN_EPI = false, bool SP2 = false>
__device__ __forceinline__ void gemm_phase(PG8_LAS unsigned char* lds, const Gemm g, const Sched& S, const Epi& E, const int wv  ) {
    int tid_ = (wv << 6) | hw_lane(); asm volatile("" : "+v"(tid_));
    const int tid = tid_, wid = __builtin_amdgcn_readfirstlane(tid >> 6), lane = tid & 63, wr = wid >> 2, wc = wid & 3, fr = lane & 15, fq = lane >> 4;
    const int K = g.K, nt = K / BK;
    unsigned voffA[2], voffB[2];
#pragma unroll
    for (int i = 0; i < 2; ++i) { int R, C; stage_rc(tid * 16 + i * 8192, R, C); const int Rb = Epi::PERM ? ((R & ~31) + perm32(R & 31)) : R;
        voffA[i] = (unsigned)(R * K + C) * 2u; voffB[i] = (unsigned)(Rb * K + C) * 2u; }
    const size_t kstep = (size_t)(BK * 2);
    const size_t hstep = (size_t)HALF * K * 2;
    const size_t tstep = 2 * hstep;
    const unsigned ldsw = (unsigned)wid * 1024u;
    const int aoff = lds_byte(wr * 64 + fr, fq * 8), boff = lds_byte(wc * 32 + fr, fq * 8);
#define PG8_SA(b, h) (((b) * 2 + (h)) * HTB)
#define PG8_SB(b, h) ((4 + (b) * 2 + (h)) * HTB)
#define PG8_STAGE(bufoff, gbase, voff) do { _Pragma("unroll") for (int _i = 0; _i < 2; ++_i) \
        __builtin_amdgcn_global_load_lds((const unsigned*)((const char*)(gbase) + (voff)[_i]), (PG8_LAS unsigned*)(lds + (bufoff) + ldsw + _i * 8192), 16, 0, 0); } while (0)
#define PG8_LDA(dst, b, h) do { _Pragma("unroll") for (int m = 0; m < 4; ++m) _Pragma("unroll") for (int k = 0; k < 2; ++k) dst[m][k] = *(const PG8_LAS bf16x8*)(lds + PG8_SA(b, h) + aoff + m * 2048 + k * 1024); } while (0)
#define PG8_LDB(dst, b, h) do { _Pragma("unroll") for (int n = 0; n < 2; ++n) _Pragma("unroll") for (int k = 0; k < 2; ++k) dst[n][k] = *(const PG8_LAS bf16x8*)(lds + PG8_SB(b, h) + boff + n * 2048 + k * 1024); } while (0)
#define PG8_MMA(ai, bj, At, Bt) do { __builtin_amdgcn_s_setprio(1); _Pragma("unroll") for (int m = 0; m < 4; ++m) _Pragma("unroll") for (int n = 0; n < 2; ++n) _Pragma("unroll") for (int k = 0; k < 2; ++k) \
        acc[ai][bj][m][n] = __builtin_amdgcn_mfma_f32_16x16x32_bf16(Bt[n][k], At[m][k], acc[ai][bj][m][n], 0, 0, 0); __builtin_amdgcn_s_setprio(0); } while (0)
#define PG8_WAIT_V(n) asm volatile("s_waitcnt vmcnt(" #n ")" ::: "memory")
#define PG8_WAIT_L(n) asm volatile("s_waitcnt lgkmcnt(" #n ")" ::: "memory")
#define PG8_BAR __builtin_amdgcn_s_barrier()
#define PG8_SCHED __builtin_amdgcn_sched_barrier(0)
    Unit cur, nxt; int ui = 0;
    if (!S.next(0, cur)) return;
    f32x4 acc[2][2][4][2];
#pragma unroll
    for (int a = 0; a < 2; ++a)
#pragma unroll
        for (int b = 0; b < 2; ++b)
#pragma unroll
            for (int m = 0; m < 4; ++m)
#pragma unroll
                for (int n = 0; n < 2; ++n) acc[a][b][m][n] = (f32x4){0.f, 0.f, 0.f, 0.f};
    bf16x8 At[4][2], B0[2][2], B1[2][2];
    const size_t rstepA = (size_t)K * 2;
    const char* cA = (const char*)g.A + g.arow(cur.pm) * rstepA; const char* cB = (const char*)g.Bt + (size_t)cur.pn * tstep;
    S.a_ready(cur);
    if constexpr (SP2) {
        PG8_STAGE(PG8_SB(0, 0), cB, voffB); PG8_STAGE(PG8_SB(0, 1), cB + hstep, voffB); PG8_STAGE(PG8_SA(0, 0), cA, voffA); PG8_STAGE(PG8_SA(0, 1), cA + hstep, voffA);
        if (wr == 1) PG8_BAR;
        PG8_WAIT_V(2); PG8_BAR;
        PG8_STAGE(PG8_SB(1, 0), cB + kstep, voffB); PG8_STAGE(PG8_SA(1, 0), cA + kstep, voffA); PG8_STAGE(PG8_SB(1, 1), cB + hstep + kstep, voffB);
        PG8_WAIT_V(6); PG8_BAR;
    } else {
        PG8_STAGE(PG8_SB(0, 0), cB, voffB); PG8_STAGE(PG8_SA(0, 0), cA, voffA); PG8_STAGE(PG8_SB(0, 1), cB + hstep, voffB); PG8_STAGE(PG8_SA(0, 1), cA + hstep, voffA);
        if (wr == 1) PG8_BAR;
        PG8_WAIT_V(4); PG8_BAR;
        PG8_STAGE(PG8_SB(1, 0), cB + kstep, voffB); PG8_STAGE(PG8_SA(1, 0), cA + kstep, voffA); PG8_STAGE(PG8_SB(1, 1), cB + hstep + kstep, voffB);
        PG8_WAIT_V(6); PG8_BAR;
    }
    for (;;) {
        const bool has_next = S.next(ui + 1, nxt);
        const char* nA = has_next ? (const char*)g.A + g.arow(nxt.pm) * rstepA : cA; const char* nB = has_next ? (const char*)g.Bt + (size_t)nxt.pn * tstep : cB;
        for (int t = 0; t < nt; t += 2) {
            const bool last = (t == nt - 2);
            const char* a1 = cA + (size_t)(t + 1) * kstep;
            const char* a2 = last ? nA : cA + (size_t)(t + 2) * kstep; const char* b2 = last ? nB : cB + (size_t)(t + 2) * kstep;
            const char* a3 = a2 + kstep; const char* b3 = b2 + kstep;
            if (last && has_next) S.a_ready(nxt);
            if constexpr (SP2) {
            PG8_LDB(B0, 0, 0); PG8_LDB(B1, 0, 1); PG8_SCHED; PG8_LDA(At, 0, 0); PG8_STAGE(PG8_SA(1, 1), a1 + hstep, voffA);
            PG8_WAIT_V(8); PG8_WAIT_L(0); PG8_BAR; PG8_MMA(0, 0, At, B0); PG8_MMA(0, 1, At, B1); PG8_BAR; PG8_SCHED;
            PG8_LDA(At, 0, 1); PG8_STAGE(PG8_SB(0, 0), b2, voffB); PG8_STAGE(PG8_SB(0, 1), b2 + hstep, voffB); PG8_STAGE(PG8_SA(0, 0), a2, voffA);
            PG8_WAIT_V(8); PG8_WAIT_L(0); PG8_BAR; PG8_MMA(1, 0, At, B0); PG8_MMA(1, 1, At, B1); PG8_BAR; PG8_SCHED;
            PG8_LDB(B0, 1, 0); PG8_LDB(B1, 1, 1); PG8_SCHED; PG8_LDA(At, 1, 0); PG8_STAGE(PG8_SA(0, 1), a2 + hstep, voffA);
            PG8_WAIT_V(8); PG8_WAIT_L(0); PG8_BAR; PG8_MMA(0, 0, At, B0); PG8_MMA(0, 1, At, B1); PG8_BAR; PG8_SCHED;
            PG8_LDA(At, 1, 1); PG8_STAGE(PG8_SB(1, 0), b3, voffB); PG8_STAGE(PG8_SB(1, 1), b3 + hstep, voffB); PG8_STAGE(PG8_SA(1, 0), a3, voffA);
            PG8_WAIT_V(8); PG8_WAIT_L(0); PG8_BAR; PG8_MMA(1, 0, At, B0); PG8_MMA(1, 1, At, B1); PG8_BAR; PG8_SCHED;
            } else {
            PG8_LDB(B0, 0, 0); PG8_SCHED; PG8_LDA(At, 0, 0); PG8_STAGE(PG8_SA(1, 1), a1 + hstep, voffA);
            PG8_WAIT_L(8); PG8_BAR; PG8_WAIT_L(0); PG8_MMA(0, 0, At, B0); PG8_BAR; PG8_SCHED;
            PG8_LDB(B1, 0, 1); PG8_STAGE(PG8_SB(0, 0), b2, voffB);
            PG8_BAR; PG8_WAIT_L(0); PG8_MMA(0, 1, At, B1); PG8_BAR;
            PG8_LDA(At, 0, 1); PG8_STAGE(PG8_SA(0, 0), a2, voffA);
            PG8_BAR; PG8_WAIT_L(0); PG8_MMA(1, 0, At, B0); PG8_BAR; PG8_SCHED;
            PG8_STAGE(PG8_SB(0, 1), b2 + hstep, voffB);
            PG8_WAIT_V(6); PG8_BAR; PG8_MMA(1, 1, At, B1); PG8_BAR;
            PG8_LDB(B0, 1, 0); PG8_SCHED; PG8_LDA(At, 1, 0); PG8_STAGE(PG8_SA(0, 1), a2 + hstep, voffA);
            PG8_WAIT_L(8); PG8_BAR; PG8_WAIT_L(0); PG8_MMA(0, 0, At, B0); PG8_BAR; PG8_SCHED;
            PG8_LDB(B1, 1, 1); PG8_STAGE(PG8_SB(1, 0), b3, voffB);
            PG8_BAR; PG8_WAIT_L(0); PG8_MMA(0, 1, At, B1); PG8_BAR;
            PG8_LDA(At, 1, 1); PG8_STAGE(PG8_SA(1, 0), a3, voffA);
            PG8_BAR; PG8_WAIT_L(0); PG8_MMA(1, 0, At, B0); PG8_BAR; PG8_SCHED;
            PG8_STAGE(PG8_SB(1, 1), b3 + hstep, voffB);
            PG8_WAIT_V(6); PG8_BAR; PG8_MMA(1, 1, At, B1); PG8_BAR;
            }
        }
        if constexpr (ALIGN_EPI) { if (wr == 0) PG8_BAR; }
        if constexpr (!Epi::AFTER_DRAIN) { E(acc, cur, wr, wc, fr, fq); S.done(cur); }
        if (!has_next) break;
#pragma unroll
        for (int a = 0; a < 2; ++a)
#pragma unroll
            for (int b = 0; b < 2; ++b)
#pragma unroll
                for (int m = 0; m < 4; ++m)
#pragma unroll
                    for (int n = 0; n < 2; ++n) acc[a][b][m][n] = (f32x4){0.f, 0.f, 0.f, 0.f};
        cur = nxt; cA = nA; cB = nB; ++ui;
        if constexpr (ALIGN_EPI) { if (wr == 1) PG8_BAR; }
    }
    PG8_WAIT_V(0);
    if constexpr (!ALIGN_EPI) { if (wr == 0) PG8_BAR; }
    PG8_BAR;
    if constexpr (Epi::AFTER_DRAIN) { E.fused(acc, cur, wr, wc, fr, fq, lds, wid, lane); S.done(cur); }
#undef PG8_SA
#undef PG8_SB
#undef PG8_STAGE
#undef PG8_LDA
#undef PG8_LDB
#undef PG8_MMA
#undef PG8_WAIT_V
#undef PG8_WAIT_L
#undef PG8_BAR
#undef PG8_SCHED
}
}
namespace att {
constexpr float SCALE = 0.08838834764831845f;
constexpr float THR = 8.f;
constexpr bool WSKIP = true;
constexpr int D = 128, NW = 8, QBLK = 32, KVBLK = 64, QB = NW * QBLK;
constexpr int SHM_V = KVBLK * D * 2, SHM_K = KVBLK * D * 2;
constexpr int ATT_LDS_BYTES = 2 * SHM_V + 2 * SHM_K + NW * 64 * 4;
constexpr int QS = 3072, KS = 3072, OS = 2048;
constexpr int WIN = 128, CTX_TILES = 4, CTXROW0 = 8192;

using bf16 = __hip_bfloat16;
typedef short bf16x8 __attribute__((ext_vector_type(8)));
typedef short s16x4 __attribute__((ext_vector_type(4)));
typedef float f32x16 __attribute__((ext_vector_type(16)));
typedef float f32x4 __attribute__((ext_vector_type(4)));
typedef unsigned u32x4 __attribute__((ext_vector_type(4)));
template <class A, class Bt> struct same_t { static constexpr bool v = false; };
template <class A> struct same_t<A, A> { static constexpr bool v = true; };

#define KSWZ(row, colB) ((row) * 256 + ((colB) ^ (((row) & 7) << 4)))
#define SBAR() __builtin_amdgcn_sched_barrier(0)
__device__ __forceinline__ int v_st(int k, int c) { const int kk = (k & ~0xC) | ((k & 4) << 1) | ((k & 8) >> 1); return ((kk >> 3) * 4 + (c >> 5)) * 512 + ((kk & 7) * 32 + (c & 31)) * 2; }
__device__ __forceinline__ int v_rd_base(int lane) { return ((lane & 3) << 3) | (((lane >> 2) & 3) << 6) | (((lane >> 4) & 1) << 5) | (((lane >> 5) & 1) << 8); }
constexpr int v_rd_off(int d0, int ks, int half) { return d0 * 512 + ks * 4096 + half * 2048; }
__device__ __forceinline__ int crow(int r, int hi) { return (r & 3) + 8 * (r >> 2) + 4 * hi; }
__device__ __forceinline__ unsigned cvtpk(float lo, float hi) {
    unsigned r; asm volatile("v_cvt_pk_bf16_f32 %0, %1, %2" : "=v"(r) : "v"(lo), "v"(hi)); return r;
}
__device__ __forceinline__ bf16x8 pack8(f32x4 a, f32x4 b) {
    u32x4 w = {cvtpk(a[0], a[1]), cvtpk(a[2], a[3]), cvtpk(b[0], b[1]), cvtpk(b[2], b[3])};
    return *reinterpret_cast<bf16x8*>(&w);
}
template <class T> __device__ __forceinline__ bf16x8 load8(const T* p) {
    if constexpr (same_t<T, float>::v) { return pack8(*(const f32x4*)p, *(const f32x4*)(p + 4)); }
    else { return *reinterpret_cast<const bf16x8*>(p); }
}
__device__ __forceinline__ void mask_tile(f32x16& p0, f32x16& p1, int dq, unsigned W) {
    const float NEG = -__builtin_inff();
#pragma unroll
    for (int r = 0; r < 16; ++r) {
        const int c = (r & 3) + 8 * (r >> 2);
        if ((unsigned)(dq - c) >= W) p0[r] = NEG;
        if ((unsigned)(dq - c - 32) >= W) p1[r] = NEG;
    }
}
__device__ __forceinline__ void partialSM(f32x16& p0, f32x16& p1, float& m_reg, float& mn, float& alpha) {
    float pmax = p0[0]; for (int r = 1; r < 16; ++r) pmax = fmaxf(pmax, p0[r]); for (int r = 0; r < 16; ++r) pmax = fmaxf(pmax, p1[r]);
    { auto rr = __builtin_amdgcn_permlane32_swap(__float_as_uint(pmax), __float_as_uint(pmax), false, false);
      pmax = fmaxf(__uint_as_float(rr[0]), __uint_as_float(rr[1])); }
    constexpr float C2 = 1.4426950408889634f * SCALE;
    if (__builtin_expect(__all((pmax - m_reg) * SCALE <= THR), 1)) { mn = m_reg; alpha = 1.f; }
    else { mn = fmaxf(m_reg, pmax); alpha = __builtin_amdgcn_exp2f((m_reg - mn) * C2); m_reg = mn; }
    const float mnL = -mn * C2;
    for (int r = 0; r < 16; ++r) p0[r] = fmaf(p0[r], C2, mnL); for (int r = 0; r < 16; ++r) p1[r] = fmaf(p1[r], C2, mnL);
    for (int r = 0; r < 16; ++r) p0[r] = __builtin_amdgcn_exp2f(p0[r]);
}
__device__ __forceinline__ void finishSM(f32x16& p0, f32x16& p1, float alpha, float& l_reg, bf16x8& pa0, bf16x8& pa1, bf16x8& pa2, bf16x8& pa3) {
    for (int r = 0; r < 16; ++r) p1[r] = __builtin_amdgcn_exp2f(p1[r]);
    float ps = 0; for (int r = 0; r < 16; ++r) ps += p0[r]; for (int r = 0; r < 16; ++r) ps += p1[r];
    { auto rr = __builtin_amdgcn_permlane32_swap(__float_as_uint(ps), __float_as_uint(ps), false, false);
      ps = __uint_as_float(rr[0]) + __uint_as_float(rr[1]); }
    l_reg = l_reg * alpha + ps;
#define PK4(P, B_, OUT) do { unsigned a0 = cvtpk(P[B_+0], P[B_+1]), a1 = cvtpk(P[B_+2], P[B_+3]);                          \
        unsigned b0 = cvtpk(P[B_+4], P[B_+5]), b1 = cvtpk(P[B_+6], P[B_+7]);                                             \
        auto r0 = __builtin_amdgcn_permlane32_swap(a0, b0, false, false); auto r1 = __builtin_amdgcn_permlane32_swap(a1, b1, false, false); \
        u32x4 w = {r0[0], r1[0], r0[1], r1[1]}; OUT = *reinterpret_cast<bf16x8*>(&w); } while (0)
    PK4(p0, 0, pa0); PK4(p0, 8, pa1); PK4(p1, 0, pa2); PK4(p1, 8, pa3);
#undef PK4
}
template <int KB, bool SK>
__device__ __forceinline__ void qkt(f32x16& p0, f32x16& p1, const char* K_lds, int r32, int hi, const bf16x8* qr, bool act) {
    if (SK && !act) { const float NEG = -__builtin_inff();
#pragma unroll
        for (int r = 0; r < 16; ++r) { p0[r] = NEG; p1[r] = NEG; } return; }
    p0 = f32x16{}; p1 = f32x16{};
    const char* kb[4];
#pragma unroll
    for (int dd = 0; dd < 4; ++dd) kb[dd] = K_lds + KB * SHM_K + KSWZ(r32, (dd * 16 + hi * 8) * 2);
#pragma unroll
    for (int d0 = 0; d0 < 8; ++d0) { const char* a = kb[d0 & 3] + (d0 >> 2) * 128;
        bf16x8 b0 = *reinterpret_cast<const bf16x8*>(a);
        bf16x8 b1 = *reinterpret_cast<const bf16x8*>(a + 32 * 256);
        p0 = __builtin_amdgcn_mfma_f32_32x32x16_bf16(b0, qr[d0], p0, 0, 0, 0);
        p1 = __builtin_amdgcn_mfma_f32_32x32x16_bf16(b1, qr[d0], p1, 0, 0, 0); }
}
template <int VB, bool SK>
__device__ __forceinline__ void pv_tile(f32x16* o, int vb0, bf16x8 pa0, bf16x8 pa1, bf16x8 pa2, bf16x8 pa3, bool act) {
    if (SK && !act) return;
#define TRRD(dst, off) asm volatile("ds_read_b64_tr_b16 %0, %1 offset:%2" : "=&v"(dst) : "v"(vb0), "i"(off) : "memory")
#define PV_D0(d0) do { s16x4 l0, l1, l2, l3, h0, h1, h2, h3; constexpr int b_ = VB * SHM_V + v_rd_off(d0, 0, 0);     \
        TRRD(l0, b_); TRRD(h0, b_ + 2048); TRRD(l1, b_ + 4096); TRRD(h1, b_ + 6144); TRRD(l2, b_ + 8192); TRRD(h2, b_ + 10240); TRRD(l3, b_ + 12288); TRRD(h3, b_ + 14336); \
        asm volatile("s_waitcnt lgkmcnt(0)" ::: "memory"); SBAR();                 \
        o[d0] = __builtin_amdgcn_mfma_f32_32x32x16_bf16(pa0, (bf16x8){l0[0], l0[1], l0[2], l0[3], h0[0], h0[1], h0[2], h0[3]}, o[d0], 0, 0, 0);   \
        o[d0] = __builtin_amdgcn_mfma_f32_32x32x16_bf16(pa1, (bf16x8){l1[0], l1[1], l1[2], l1[3], h1[0], h1[1], h1[2], h1[3]}, o[d0], 0, 0, 0);   \
        o[d0] = __builtin_amdgcn_mfma_f32_32x32x16_bf16(pa2, (bf16x8){l2[0], l2[1], l2[2], l2[3], h2[0], h2[1], h2[2], h2[3]}, o[d0], 0, 0, 0);   \
        o[d0] = __builtin_amdgcn_mfma_f32_32x32x16_bf16(pa3, (bf16x8){l3[0], l3[1], l3[2], l3[3], h3[0], h3[1], h3[2], h3[3]}, o[d0], 0, 0, 0); } while (0)
    PV_D0(0); PV_D0(1); PV_D0(2); PV_D0(3);
#undef PV_D0
#undef TRRD
}

template <class TIn, class TOut> struct BlockRef { const TIn* Q; const TIn* K; const TIn* V; TOut* O; int P0; int jlo, ntb; float m0; };
template <class TIn, class TOut> __device__ __forceinline__ int krow0(const BlockRef<TIn, TOut>& b) { return b.ntb > 0 ? b.jlo * KVBLK : CTXROW0; }
template <class TIn> struct Seam {
    bf16x8 qr[8];
    bf16x8 st_v0, st_v1, st_k0, st_k1; f32x4 sf0, sf1, sf2, sf3;
    f32x4 tq[16];
};
__device__ __forceinline__ int swa_jlo(int P0, int W) { const int lowk = P0 - W + 1; return lowk > 0 ? lowk / KVBLK : 0; }
#define ROW(p, k0, rr) ((p) + (size_t)((k0) + (rr)) * KS + sc)
#define VMW() asm volatile("s_waitcnt vmcnt(0)" ::: "memory")
#define VMWN(n) asm volatile("s_waitcnt vmcnt(%0)" :: "i"(n) : "memory")
#define SLOAD_H(Kp, Vp, k0) do { S.st_v0 = load8<TIn>(ROW(Vp, k0, sr)); S.st_v1 = load8<TIn>(ROW(Vp, k0, 32 + sr));              \
                         S.st_k0 = load8<TIn>(ROW(Kp, k0, sr)); S.st_k1 = load8<TIn>(ROW(Kp, k0, 32 + sr)); } while (0)
#define SWRITE_HK(bf) do { *(bf16x8*)(K_lds + (bf) * SHM_K + kws) = S.st_k0; *(bf16x8*)(K_lds + (bf) * SHM_K + kws + 32 * 256) = S.st_k1; } while (0)
#define SWRITE_HV(bf) do { *(bf16x8*)(V_lds + (bf) * SHM_V + vst0) = S.st_v0; *(bf16x8*)(V_lds + (bf) * SHM_V + vst1) = S.st_v1; } while (0)
#define SWRITE_H(bf) do { SWRITE_HV(bf); SWRITE_HK(bf); } while (0)
#define SLOAD_F(p, k0) do { S.sf0 = *(const f32x4*)ROW(p, k0, sr); S.sf1 = *(const f32x4*)(ROW(p, k0, sr) + 4);                \
                            S.sf2 = *(const f32x4*)ROW(p, k0, 32 + sr); S.sf3 = *(const f32x4*)(ROW(p, k0, 32 + sr) + 4); } while (0)
#define SWRITE_KF(bf) do { *(bf16x8*)(K_lds + (bf) * SHM_K + kws) = pack8(S.sf0, S.sf1); *(bf16x8*)(K_lds + (bf) * SHM_K + kws + 32 * 256) = pack8(S.sf2, S.sf3); } while (0)
#define SWRITE_VF(bf) do { *(bf16x8*)(V_lds + (bf) * SHM_V + vst0) = pack8(S.sf0, S.sf1); *(bf16x8*)(V_lds + (bf) * SHM_V + vst1) = pack8(S.sf2, S.sf3); } while (0)
template <class TIn, class TOut>
__device__ __forceinline__ void causal_swa_prime(const BlockRef<TIn, TOut>& cur, char* lds, Seam<TIn>& S, const int wv) {
    constexpr bool F32 = same_t<TIn, float>::v;
    int tid_ = (wv << 6) | hw_lane(); asm volatile("" : "+v"(tid_));
    const int tid = tid_, wid = __builtin_amdgcn_readfirstlane(tid >> 6), lane = tid & 63, r32 = lane & 31, hi = lane >> 5;
    const int sr = tid >> 4, sc = (tid & 15) * 8, kws = KSWZ(sr, sc * 2); char* K_lds = lds + 2 * SHM_V;
    const int kb0 = krow0(cur);
    for (int d0 = 0; d0 < 8; ++d0) S.qr[d0] = load8<TIn>(cur.Q + (size_t)(wid * QBLK + r32) * QS + d0 * 16 + hi * 8);
    if constexpr (F32) { SLOAD_F((const float*)cur.K, kb0); VMW(); SWRITE_KF(0); SBAR(); SLOAD_F((const float*)cur.V, kb0); }
    else { SLOAD_H(cur.K, cur.V, kb0); VMW(); SWRITE_HK(0); }
    __syncthreads();
}
template <class TIn, class TOut>
__device__ __forceinline__ void causal_swa_block(const BlockRef<TIn, TOut>& cur, const BlockRef<TIn, TOut>& nxt, char* lds, Seam<TIn>& S, const int wv) {
    constexpr bool F32 = same_t<TIn, float>::v;
    int tid_ = (wv << 6) | hw_lane(); asm volatile("" : "+v"(tid_));
    const int tid = tid_, wid = __builtin_amdgcn_readfirstlane(tid >> 6), lane = tid & 63, r32 = lane & 31, hi = lane >> 5;
    const int j_lo = cur.jlo, NTB = cur.ntb;
    const int NT = NTB + CTX_TILES;
    const int kbn = krow0(nxt);
    const int qlo = cur.P0 + wid * QBLK, qm = qlo + r32 - 4 * hi;
    char* V_lds = lds; char* K_lds = lds + 2 * SHM_V;
    float* ws = (float*)(lds + 2 * SHM_V + 2 * SHM_K) + wid * 64; float* li_l = ws, * al_l = ws + 32;
    float m_reg = cur.m0, l_reg = 1.f; f32x16 o[4] = {};
    const int sr = tid >> 4, sc = (tid & 15) * 8, vst0 = v_st(sr, sc), vst1 = v_st(32 + sr, sc), kws = KSWZ(sr, sc * 2);
    const int vb0 = (int)(uintptr_t)V_lds + v_rd_base(lane);
    const TIn* Kh = cur.K; const TIn* Vh = cur.V;
#define RESC(a) do { if (__any((a) < 1.f)) { if (hi == 0) al_l[r32] = (a); asm volatile("s_waitcnt lgkmcnt(0)" ::: "memory");              \
                     for (int d_ = 0; d_ < 4; ++d_) for (int r = 0; r < 16; ++r) o[d_][r] *= al_l[crow(r, hi)]; } } while (0)
#define KBASE(t) ((j_lo + (t)) * KVBLK)
#define KROW(t) (((t) < NTB) ? KBASE(t) : CTXROW0 + ((t) - NTB) * KVBLK)
#define ACT(t) ((t) >= NTB || (KBASE(t) <= qlo + QBLK - 1 + WIN && KBASE(t) + KVBLK - 1 >= qlo - WIN))
#define MASKT(P0_, P1_, t) do { const int kb_ = KBASE(t); if ((t) < NTB && (!SK || ACT(t)) && (kb_ + KVBLK - 1 > qlo + WIN || kb_ < qlo + QBLK - 1 - WIN)) mask_tile(P0_, P1_, qm - kb_ + WIN, (unsigned)(2 * WIN + 1)); } while (0)
    constexpr int NQL = F32 ? 16 : 8;
    constexpr bool SK = WSKIP && !F32;
#define SEAM_K0() do { VMWN(NQL); if constexpr (F32) { SWRITE_KF(0); SBAR(); SLOAD_F((const float*)nxt.V, kbn); } else { SWRITE_HK(0); } SBAR(); } while (0)
    f32x16 pA0, pA1, pB0, pB1; float mnA, mnB, alA, alB; bf16x8 pa0, pa1, pa2, pa3;
    if constexpr (F32) { VMW(); SWRITE_VF(0); SBAR(); } else { SWRITE_HV(0); SBAR(); }
    if (NT > 1) { if constexpr (F32) SLOAD_F((const float*)Kh, KROW(1)); else SLOAD_H(Kh, Vh, KROW(1)); }
    SBAR(); qkt<0, SK>(pA0, pA1, K_lds, r32, hi, S.qr, ACT(0));
    if constexpr (F32) { if (NT > 1) { VMW(); SWRITE_KF(1); SBAR(); SLOAD_F((const float*)Vh, KROW(1)); } }
    MASKT(pA0, pA1, 0); partialSM(pA0, pA1, m_reg, mnA, alA);
    if (NT > 1) { VMW(); if constexpr (F32) { SWRITE_VF(1); SBAR(); if (NT > 2) SLOAD_F((const float*)Kh, KROW(2)); } else SWRITE_H(1); }
    __syncthreads();
#define HALF_STEP(PX0, PX1, mnX, alX, PY0, PY1, alY, t, KB, VB, SB) do {                                                      \
        SBAR(); qkt<KB, SK>(PX0, PX1, K_lds, r32, hi, S.qr, ACT(t));                                             \
        finishSM(PY0, PY1, alY, l_reg, pa0, pa1, pa2, pa3); SBAR();                                                           \
        if ((t) + 1 < NT) { if constexpr (F32) { VMW(); SWRITE_KF(SB); SBAR(); SLOAD_F((const float*)Vh, KROW((t) + 1)); }  \
                            else { SLOAD_H(Kh, Vh, KROW((t) + 1)); } SBAR(); }                                               \
        pv_tile<VB, SK>(o, vb0, pa0, pa1, pa2, pa3, ACT((t) - 1)); MASKT(PX0, PX1, (t)); partialSM(PX0, PX1, m_reg, mnX, alX);                                        \
        __syncthreads();                                                                                                      \
        if ((t) + 1 < NT) { VMW(); if constexpr (F32) { SWRITE_VF(SB); SBAR(); if ((t) + 2 < NT) SLOAD_F((const float*)Kh, KROW((t) + 2)); } \
                            else { SWRITE_H(SB); } }                                                                          \
        RESC(alX); __syncthreads(); } while (0)
    for (int t = 1; t + 1 < NT; t += 2) {
        HALF_STEP(pB0, pB1, mnB, alB, pA0, pA1, alA, t, 1, 0, 0);
        HALF_STEP(pA0, pA1, mnA, alA, pB0, pB1, alB, t + 1, 0, 1, 1);
    }
    const bool even = (NT & 1) == 0;
    if (even) { SBAR(); qkt<1, SK>(pB0, pB1, K_lds, r32, hi, S.qr, ACT(NT - 1)); SBAR(); }
#define QROW(e) (nxt.Q + (size_t)(wid * QBLK + r32) * QS + ((e) >> 1) * 16 + hi * 8 + ((e) & 1) * 4)
    if constexpr (F32) { SLOAD_F((const float*)nxt.K, kbn); SBAR();
#pragma unroll
        for (int e = 0; e < 8; ++e) S.tq[e] = *(const f32x4*)QROW(e); }
    else { SLOAD_H(nxt.K, nxt.V, kbn); SBAR();
#pragma unroll
        for (int d0 = 0; d0 < 8; ++d0) S.qr[d0] = load8<TIn>(nxt.Q + (size_t)(wid * QBLK + r32) * QS + d0 * 16 + hi * 8); }
    SBAR();
    finishSM(pA0, pA1, alA, l_reg, pa0, pa1, pa2, pa3); SBAR();
    if constexpr (F32) {
#pragma unroll
        for (int e = 8; e < 16; ++e) S.tq[e] = *(const f32x4*)QROW(e); SBAR(); }
#undef QROW
    pv_tile<0, SK>(o, vb0, pa0, pa1, pa2, pa3, ACT(even ? NT - 2 : NT - 1));
    if (even) { MASKT(pB0, pB1, NT - 1); partialSM(pB0, pB1, m_reg, mnB, alB); __syncthreads(); RESC(alB);
        finishSM(pB0, pB1, alB, l_reg, pa0, pa1, pa2, pa3); SBAR(); pv_tile<1, SK>(o, vb0, pa0, pa1, pa2, pa3, ACT(NT - 1)); }
    SBAR(); SEAM_K0();
    if (hi == 0) li_l[r32] = l_reg; asm volatile("s_waitcnt lgkmcnt(0)" ::: "memory");
    float rli[16];
#pragma unroll
    for (int r = 0; r < 16; ++r) rli[r] = __builtin_amdgcn_rcpf(li_l[crow(r, hi)]);
    int r32o = r32, hio = hi; asm volatile("" : "+v"(r32o), "+v"(hio));
    char* Owb = (char*)(cur.O + (size_t)(wid * QBLK) * OS);
#pragma unroll
    for (int r = 0; r < 16; ++r) { const unsigned ooff = (unsigned)((crow(r, hio) * OS + r32o) * 2);
#pragma unroll
        for (int d0 = 0; d0 < 4; ++d0) { const float v = o[d0][r] * rli[r];
            if constexpr (same_t<TOut, float>::v) { static_assert(!same_t<TOut, float>::v, "bf16 O only"); }
            else { const float vn = __int_as_float(__builtin_amdgcn_mov_dpp(__float_as_int(v), 0xB1, 0xF, 0xF, true));
                   if ((r32o & 1) == 0) *(unsigned*)(Owb + ooff + d0 * 64) = cvtpk(v, vn); } } }
    if constexpr (F32) {
#pragma unroll
        for (int d0 = 0; d0 < 8; ++d0) S.qr[d0] = pack8(S.tq[2 * d0], S.tq[2 * d0 + 1]); }
    __syncthreads();
#undef RESC
#undef KBASE
#undef KROW
#undef ACT
#undef MASKT
#undef SEAM_K0
#undef HALF_STEP
}
#undef ROW
#undef VMW
#undef VMWN
#undef SLOAD_H
#undef SWRITE_HK
#undef SWRITE_HV
#undef SWRITE_H
#undef SLOAD_F
#undef SWRITE_KF
#undef SWRITE_VF
}
constexpr int DM = 2048, SEQ = 8192, CTXL = 256, MR = SEQ + CTXL, DEPTH = 4, HDIM = 128, NHQ = 16, NHKV = 4;
constexpr int NQKV = 3072, DFF = 5632, NUP = 2 * DFF, NIN = 3 * DM, NADA = 6 * DM;
constexpr float RMS_EPS = 1e-6f;
constexpr int NWAVES = 8;

constexpr size_t MiB = 1u << 20;
constexpr size_t WS_CTL = 0, CTL_ZERO_BYTES = 1 * MiB;
constexpr size_t WS_MOD = 1 * MiB;
constexpr size_t WS_ROPE = WS_MOD + 512 * 1024;
constexpr size_t SZ_WQKV = (size_t)NQKV * DM * 2, SZ_WO = (size_t)DM * DM * 2, SZ_WIN = (size_t)NIN * DM * 2, SZ_WUP = (size_t)NUP * DM * 2, SZ_WDN = (size_t)DM * DFF * 2;
constexpr size_t WS_WQKV = 2 * MiB, WS_WO = WS_WQKV + 2 * SZ_WQKV, WS_WIN = WS_WO + 2 * SZ_WO, WS_WOUT = WS_WIN + 2 * SZ_WIN, WS_WUP = WS_WOUT + 2 * SZ_WO, WS_WDN = WS_WUP + 4 * SZ_WUP;
constexpr size_t WS_XR = WS_WDN + 4 * SZ_WDN;
constexpr size_t WS_HN = WS_XR + (size_t)MR * DM * 4;
constexpr int HN_LAT0 = 1, HN_CTX0 = SEQ + 2;
constexpr size_t WS_R1 = WS_HN + (size_t)(MR + 8) * DM * 2;
constexpr size_t WS_GV = WS_R1, WS_QKV = WS_R1, WS_AO = WS_R1 + (size_t)MR * NQKV * 2, WS_BCV = WS_R1, WS_Z = WS_R1 + (size_t)MR * NIN * 2;
constexpr size_t WS_U = WS_R1 + (size_t)MR * NUP * 2;
constexpr size_t WS_BG1 = WS_U + (size_t)MR * DFF * 2, SZ_BG1 = (size_t)4 * 2 * NIN * 4, WS_BUP = WS_BG1 + DEPTH * SZ_BG1, SZ_BUP = (size_t)4 * 2 * NUP * 4;
constexpr size_t WS_END = WS_BUP + DEPTH * SZ_BUP;
constexpr int CW_BAR = 4096;
constexpr size_t CTL_ROWSS = 64 * 1024;
static_assert(CTL_ROWSS + (size_t)8 * MR * 4 <= CTL_ZERO_BYTES, "CTL map");

constexpr int RING_OFF = 0, RING_BYTES = 131072;
constexpr int LDSCTL_OFF = RING_BYTES, MISC_OFF = LDSCTL_OFF + 320;
constexpr int XCH_OFF = MISC_OFF + 128, XCH_BYTES = 4096;
constexpr int LDS_BYTES = 147456;
static_assert(XCH_OFF % 16 == 0 && XCH_OFF + XCH_BYTES <= LDS_BYTES, "LDS map");

#define GAS __attribute__((address_space(1)))
#define LAS __attribute__((address_space(3)))
typedef unsigned short bf16;
typedef unsigned v4u __attribute__((ext_vector_type(4)));
typedef unsigned v2u __attribute__((ext_vector_type(2)));
typedef float f32x4 __attribute__((ext_vector_type(4)));
typedef GAS unsigned gu32;
#define RLX_AGENT __ATOMIC_RELAXED, __HIP_MEMORY_SCOPE_AGENT
#define LDS_WAIT() asm volatile("s_waitcnt lgkmcnt(0)" ::: "memory")
__device__ __forceinline__ unsigned pk2(float lo, float hi) { return pg8::cvt_pk_bf16(lo, hi); }
__device__ __forceinline__ float bf_lo(unsigned w) { return __uint_as_float(w << 16); }
__device__ __forceinline__ float bf_hi(unsigned w) { return __uint_as_float(w & 0xffff0000u); }

#define XB_TMO      128
#define XB_XCNT(j)  (256  + 64 * (j))
#define XB_XSUB(j)  (1280 + 64 * (j))
#define XB_XGEN(j)  (2304 + 64 * (j))
#define XB_TOP      3328
#define XB_TOPGEN   3392
#define XCD_BAR_WORDS 3456
#define XB_SPIN_CAP (1u << 18)

__device__ __forceinline__ unsigned xb_ld(unsigned* p)              { return __hip_atomic_load(p, __ATOMIC_RELAXED, __HIP_MEMORY_SCOPE_AGENT); }
__device__ __forceinline__ unsigned xb_add(unsigned* p, unsigned v) { return __hip_atomic_fetch_add(p, v, __ATOMIC_RELAXED, __HIP_MEMORY_SCOPE_AGENT); }
__device__ __forceinline__ unsigned xb_xcc_id() { return (unsigned)__builtin_amdgcn_s_getreg((3 << 11) | 20) & 0xFu; }
#define XB_SPIN(cond, bar) do { unsigned _sp = 0; while (cond) { __builtin_amdgcn_s_sleep(1); \
    if ((++_sp & 255u) == 0u) { if (xb_ld(&(bar)[XB_TMO])) break; if (_sp > XB_SPIN_CAP) { atomicAdd(&(bar)[XB_TMO], 1u); break; } } } } while (0)

struct XcdBarrier {
    unsigned* bar; unsigned x;
    volatile LAS unsigned* st;
};
__device__ __forceinline__ XcdBarrier xcd_barrier_post(unsigned* bar, volatile LAS unsigned* st, const bool t0  ) {
    XcdBarrier b; b.bar = bar; b.x = xb_xcc_id(); b.st = st;
    if (t0) (void)xb_add(&bar[XB_XCNT(b.x)], 1u);
    return b;
}
__device__ __forceinline__ void xcd_barrier_complete(unsigned* bar, unsigned x, unsigned& nloc, unsigned& nx) {
    const unsigned G = gridDim.x * gridDim.y * gridDim.z;
    unsigned sum, cnt, mine, sp = 0u;
    for (;;) {
        sum = 0u; cnt = 0u; mine = 0u;
#pragma unroll
        for (unsigned j = 0; j < 16; ++j) { const unsigned c = xb_ld(&bar[XB_XCNT(j)]); sum += c; cnt += (c > 0u) ? 1u : 0u; mine = (j == x) ? c : mine; }
        if (sum == G) break;
        __builtin_amdgcn_s_sleep(1);
        if ((++sp & 255u) == 0u) { if (xb_ld(&bar[XB_TMO])) break; if (sp > XB_SPIN_CAP) { atomicAdd(&bar[XB_TMO], 1u); break; } }
    }
    nloc = mine > 0u ? mine : 1u; nx = cnt > 0u ? cnt : 1u;
}
__device__ __forceinline__ void xcd_barrier(const XcdBarrier& b, const int wv) {
    asm volatile("s_waitcnt vmcnt(0)" ::: "memory");
    __syncthreads();
    if (wv == 0 && hw_lane() == 0) {
        unsigned long long bar_i = (unsigned long long)b.bar; asm volatile("" : "+s"(bar_i));
        unsigned* bar = (unsigned*)(GAS unsigned*)bar_i;
        __builtin_amdgcn_s_waitcnt(0);
        unsigned nloc = b.st[0], nx = b.st[1];
        if (nloc == 0u) { xcd_barrier_complete(bar, b.x, nloc, nx); b.st[0] = nloc; b.st[1] = nx; }
        const unsigned old = xb_add(&bar[XB_XSUB(b.x)], 1u);
        const unsigned gen = old / nloc;
        if (old + 1u == (gen + 1u) * nloc) {
            __builtin_amdgcn_fence(__ATOMIC_RELEASE, "agent");
            asm volatile("s_waitcnt vmcnt(0)" ::: "memory");
            const unsigned og = xb_add(&bar[XB_TOP], 1u);
            const unsigned tg = og / nx;
            if (og + 1u == (tg + 1u) * nx) xb_add(&bar[XB_TOPGEN], 1u);
            else XB_SPIN(xb_ld(&bar[XB_TOPGEN]) == tg, bar);
            __builtin_amdgcn_fence(__ATOMIC_ACQUIRE, "agent");
            xb_add(&bar[XB_XGEN(b.x)], 1u);
            asm volatile("s_waitcnt vmcnt(0)" ::: "memory");
        } else {
            XB_SPIN(xb_ld(&bar[XB_XGEN(b.x)]) == gen, bar);
            __builtin_amdgcn_fence(__ATOMIC_ACQUIRE, "agent");
            asm volatile("s_waitcnt vmcnt(0)" ::: "memory");
        }
    }
    __syncthreads();
}

struct Frame {
    LAS unsigned char* lds; char* ldsg;
    volatile LAS unsigned* MISC;
    unsigned char* ws;
    int vcu, G;
    int wv;
    float* out;
};
__device__ __forceinline__ const float* inptr(const Frame& F, int i) {
    const LAS unsigned* t = (const LAS unsigned*)(F.lds + LDSCTL_OFF + 64) + 2 * i;
    const unsigned lo = __builtin_amdgcn_readfirstlane(t[0]), hi = __builtin_amdgcn_readfirstlane(t[1]);
    return (const float*)(const GAS float*)(((unsigned long long)hi << 32) | lo);
}
#define PHASE_IDS int tid_ = (F.wv << 6) | hw_lane(); asm volatile("" : "+v"(tid_)); const int tid = tid_, lane = tid & 63, wave = __builtin_amdgcn_readfirstlane(tid >> 6); (void)lane; (void)wave
template <int CTRL> __device__ __forceinline__ float dppf(float v) { return __int_as_float(__builtin_amdgcn_mov_dpp(__float_as_int(v), CTRL, 0xF, 0xF, true)); }
#define DPP_XOR1 0xB1
#define DPP_XOR2 0x4E
#define DPP_HMIRROR 0x141
#define DPP_MIRROR 0x140
__device__ __forceinline__ float row16_sum(float v) {
    v += dppf<DPP_XOR1>(v); v += dppf<DPP_XOR2>(v); v += dppf<DPP_HMIRROR>(v); v += dppf<DPP_MIRROR>(v); return v;
}
template <int PAT> __device__ __forceinline__ float swz_xor(float v) { return __int_as_float(__builtin_amdgcn_ds_swizzle(__float_as_int(v), PAT)); }
__device__ __forceinline__ float wave_sum(float v) {
    v = row16_sum(v); v += swz_xor<0x401F>(v);
    const auto rr = __builtin_amdgcn_permlane32_swap(__float_as_uint(v), __float_as_uint(v), false, false);
    return __uint_as_float(rr[0]) + __uint_as_float(rr[1]);
}
__device__ __forceinline__ float silu_f(float x) { return x / (1.f + __expf(-x)); }

template <bool GLU_PERM, bool BIAS>
__device__ __forceinline__ float p0_transpose_item(const float* W, int K, int N, bf16* WT, LAS float* scr, int kb, int nb, int lane, const LAS float* shv = nullptr) {
    const int k0 = 64 * kb, n0 = 32 * nb;
    const int d0 = GLU_PERM ? ((n0 % DFF) / 128) * 256 + (n0 >= DFF ? 128 : 0) + (n0 % DFF) % 128 : n0;
#pragma unroll 8
    for (int i = 0; i < 32; ++i) { const int kk = 2 * i + (lane >> 5); scr[kk * 33 + (lane & 31)] = W[(size_t)(k0 + kk) * N + n0 + (lane & 31)]; }
    LDS_WAIT(); asm volatile("" ::: "memory");
    const int c = lane & 7;
#pragma unroll
    for (int j = 0; j < 4; ++j) { const int n = (lane >> 3) + 8 * j; const LAS float* s = scr + (8 * c) * 33 + n;
        v4u o; o.x = pk2(s[0 * 33], s[1 * 33]); o.y = pk2(s[2 * 33], s[3 * 33]); o.z = pk2(s[4 * 33], s[5 * 33]); o.w = pk2(s[6 * 33], s[7 * 33]);
        *(GAS v4u*)(WT + (size_t)(d0 + n) * K + k0 + 8 * c) = o; }
    float p = 0.f;
    if (BIAS) { const int sidx = lane >> 5, nn = lane & 31; const LAS float* sh = shv + sidx * DM + k0;
#pragma unroll 16
        for (int kk = 0; kk < 64; ++kk) p += sh[kk] * scr[kk * 33 + nn]; }
    LDS_WAIT(); asm volatile("" ::: "memory");
    return p;
}

template <bool BIAS_PASS>
__device__ __forceinline__ void p0_weights(Frame& F) {
    PHASE_IDS;
    const float* mod = (const float*)(F.ws + WS_MOD);
    LAS float* scr = (LAS float*)(F.lds + RING_OFF + wave * 12288 + (BIAS_PASS ? 0 : 32768));
    LAS float* shv = (LAS float*)(F.lds + RING_OFF + 8 * 12288);
    constexpr int U_QKV = (NQKV / 256) * (DM / 512), U_O = (DM / 256) * (DM / 512), U_IN = (NIN / 256) * (DM / 512), U_UP = (NUP / 256) * (DM / 512), U_DN = (DM / 256) * (DFF / 512);
    constexpr int NUNITS = BIAS_PASS ? 2 * U_QKV + 2 * U_IN + 4 * U_UP : 2 * U_O + 2 * U_O + 4 * U_DN;
    float* bg1 = (float*)(F.ws + WS_BG1); float* bup = (float*)(F.ws + WS_BUP);
    int cur_mat = -1;
    for (int un = F.vcu; un < NUNITS; un += F.G) {
        int r = un, mt, j;
        if (BIAS_PASS) {
            if (r < 2 * U_QKV) { mt = 0; j = r / U_QKV; r %= U_QKV; }
            else if ((r -= 2 * U_QKV) < 2 * U_IN) { mt = 2; j = r / U_IN; r %= U_IN; }
            else { r -= 2 * U_IN; mt = 4; j = r / U_UP; r %= U_UP; }
        } else {
            if (r < 2 * U_O) { mt = 1; j = r / U_O; r %= U_O; }
            else if ((r -= 2 * U_O) < 2 * U_O) { mt = 3; j = r / U_O; r %= U_O; }
            else { r -= 2 * U_O; mt = 5; j = r / U_DN; r %= U_DN; }
        }
        const int N = mt == 0 ? NQKV : mt == 2 ? NIN : mt == 4 ? NUP : DM;
        const int nstrip = N / 256, kq = r / nstrip, strip = r % nstrip, nb = strip * 8 + wave;
        const int want = mt == 0 ? (2 * j) * 2 : mt == 2 ? (2 * j + 1) * 2 : mt == 4 ? j * 2 + 1 : -1;
        if (BIAS_PASS && want != cur_mat) {
            __syncthreads();
            const int l = want >> 1, chunk = (want & 1) ? 3 : 0;
            for (int k = tid; k < 2 * DM; k += NWAVES * 64) shv[k] = mod[(size_t)(l * 2 + (k >= DM ? 1 : 0)) * NADA + chunk * DM + (k & (DM - 1))];
            cur_mat = want;
            __syncthreads();
        }
        float bacc = 0.f;
        for (int kbi = 0; kbi < 8; ++kbi) {
            const int kb = kq * 8 + kbi;
            if (BIAS_PASS) {
                if (mt == 0) bacc += p0_transpose_item<false, true>(inptr(F, 6) + (size_t)j * DM * NQKV, DM, NQKV, (bf16*)(F.ws + WS_WQKV + j * SZ_WQKV), scr, kb, nb, lane, shv);
                else if (mt == 2) bacc += p0_transpose_item<false, true>(inptr(F, 11) + (size_t)j * DM * NIN, DM, NIN, (bf16*)(F.ws + WS_WIN + j * SZ_WIN), scr, kb, nb, lane, shv);
                else bacc += p0_transpose_item<true, true>(inptr(F, 14) + (size_t)j * DM * NUP, DM, NUP, (bf16*)(F.ws + WS_WUP + j * SZ_WUP), scr, kb, nb, lane, shv);
            } else {
                if (mt == 1) p0_transpose_item<false, false>(inptr(F, 7) + (size_t)j * DM * DM, DM, DM, (bf16*)(F.ws + WS_WO + j * SZ_WO), scr, kb, nb, lane);
                else if (mt == 3) p0_transpose_item<false, false>(inptr(F, 13) + (size_t)j * DM * DM, DM, DM, (bf16*)(F.ws + WS_WOUT + j * SZ_WO), scr, kb, nb, lane);
                else p0_transpose_item<false, false>(inptr(F, 17) + (size_t)j * DFF * DM, DFF, DM, (bf16*)(F.ws + WS_WDN + j * SZ_WDN), scr, kb, nb, lane);
            }
        }
        if (BIAS_PASS) {
            float* bp = mt == 4 ? bup + (size_t)j * (SZ_BUP / 4) : bg1 + (size_t)(mt == 0 ? 2 * j : 2 * j + 1) * (SZ_BG1 / 4);
            bp[(size_t)(kq * 2 + (lane >> 5)) * N + nb * 32 + (lane & 31)] = bacc;
        }
    }
}

__device__ __forceinline__ void p0a_phase(Frame& F) {
    PHASE_IDS;
    {
        LAS float* sact = (LAS float*)(F.lds);
        LAS float* red = (LAS float*)(F.lds + 16384);
        const float* cv = inptr(F, 1); const float* ccv = inptr(F, 3);
        for (int k = tid; k < DM; k += NWAVES * 64) { sact[k] = silu_f(cv[k]); sact[DM + k] = silu_f(ccv[k]); }
        __syncthreads();
        float* mod = (float*)(F.ws + WS_MOD);
        const int col4 = tid % 48, rg = tid / 48;
        for (int u = F.vcu; u < DEPTH * 64; u += F.G) {
            const int l = u >> 6, c0 = (u & 63) * 192;
            if (rg < 10) {
                f32x4 a0 = {0.f, 0.f, 0.f, 0.f}, a1 = {0.f, 0.f, 0.f, 0.f};
                const float* wp = inptr(F, 4) + (size_t)l * DM * NADA + c0 + 4 * col4;
#pragma unroll 8
                for (int k = rg; k < DM; k += 10) { const f32x4 w = *(const f32x4*)(wp + (size_t)k * NADA); const float s0 = sact[k], s1 = sact[DM + k]; a0 += w * s0; a1 += w * s1; }
                *(LAS f32x4*)(red + (rg * 2 + 0) * 192 + 4 * col4) = a0; *(LAS f32x4*)(red + (rg * 2 + 1) * 192 + 4 * col4) = a1;
            }
            __syncthreads();
            if (tid < 384) { const int sI = tid / 192, jj = tid % 192; float sum = 0.f;
#pragma unroll
                for (int r = 0; r < 10; ++r) sum += red[(r * 2 + sI) * 192 + jj];
                mod[(size_t)(l * 2 + sI) * NADA + c0 + jj] = sum + inptr(F, 5)[l * NADA + c0 + jj]; }
            __syncthreads();
        }
    }
    {
        float2* rt = (float2*)(F.ws + WS_ROPE);
        for (int i = F.vcu * (NWAVES * 64) + tid; i < 192 * 32; i += F.G * NWAVES * 64) {
            const int q = i >> 5, p = i & 31, pos = q < 128 ? q : q - 128;
            const float inv = exp2f(-(float)p * (13.287712379549449f / 32.f));
            const float ang = (float)pos * inv;
            rt[i] = make_float2(__cosf(ang), __sinf(ang));
        }
    }
    if (F.vcu == 0) { v4u* z0 = (v4u*)(F.ws + WS_HN); v4u* z1 = (v4u*)(F.ws + WS_HN + (size_t)(SEQ + 1) * DM * 2); const v4u zz = {0u, 0u, 0u, 0u};
        for (int i = tid; i < DM * 2 / 16; i += NWAVES * 64) { z0[i] = zz; z1[i] = zz; } }
    p0_weights<false>(F);
}

__device__ __forceinline__ void p0b_phase(Frame& F) {
    PHASE_IDS;
    const float* mod = (const float*)(F.ws + WS_MOD);
    {
        const int gw = F.vcu * NWAVES + wave, NGW = F.G * NWAVES;
        bf16* HN = (bf16*)(F.ws + WS_HN); float* rowss = (float*)(F.ws + WS_CTL + CTL_ROWSS);
        for (int m = gw; m < MR; m += NGW) {
            const float* md = mod + (m >= SEQ ? NADA : 0) + DM;
            const f32x4* xr = (const f32x4*)(m < SEQ ? inptr(F, 0) + (size_t)m * DM : inptr(F, 2) + (size_t)(m - SEQ) * DM) + lane;
            f32x4 v[8]; float ssum = 0.f;
#pragma unroll
            for (int j = 0; j < 8; ++j) { v[j] = xr[64 * j]; ssum += (v[j].x * v[j].x + v[j].y * v[j].y) + (v[j].z * v[j].z + v[j].w * v[j].w); }
            ssum = wave_sum(ssum);
            if (lane == 0) rowss[m] = ssum;
            v2u* o8 = (v2u*)(HN + (size_t)(m < SEQ ? HN_LAT0 + m : HN_CTX0 + (m - SEQ)) * DM) + lane;
#pragma unroll
            for (int j = 0; j < 8; ++j) { const f32x4 sc = ((const f32x4*)md)[lane + 64 * j]; const f32x4 o = v[j] * (1.f + sc); v2u w; w.x = pk2(o.x, o.y); w.y = pk2(o.z, o.w); o8[64 * j] = w; }
        }
    }
    p0_weights<true>(F);
}

__device__ __forceinline__ void qkr_phase(Frame& F, int M, const float* qg, const float* kg) {
    PHASE_IDS;
    const int gw = F.vcu * NWAVES + wave, NGW = F.G * NWAVES;
    bf16* QKV = (bf16*)(F.ws + WS_QKV);
    const float2* rowtab = (const float2*)(F.ws + WS_ROPE); const float2* coltab = rowtab + 128 * 32;
    const int i = lane & 15, grp = lane >> 4;
    for (int m = gw; m < M; m += NGW) {
        const bool lat = m < SEQ;
        const int a = i >> 3, pos = a == 0 ? (m >> 6) : (m & 63);
        const float2* tab = (a == 0 ? rowtab : coltab) + pos * 32 + (i & 3) * 8;
        const bool second = (i & 4) != 0;
#pragma unroll
        for (int it = 0; it < 5; ++it) {
            const int head = it * 4 + grp;
            v4u* p = (v4u*)(QKV + (size_t)m * NQKV + head * HDIM + 8 * i);
            const v4u raw = *p;
            float x[8] = {bf_lo(raw.x), bf_hi(raw.x), bf_lo(raw.y), bf_hi(raw.y), bf_lo(raw.z), bf_hi(raw.z), bf_lo(raw.w), bf_hi(raw.w)};
            float ss = 0.f;
#pragma unroll
            for (int e = 0; e < 8; ++e) ss += x[e] * x[e];
            ss = row16_sum(ss);
            const float r = rsqrtf(ss * (1.f / HDIM) + RMS_EPS);
            const float* g = (head < NHQ ? qg : kg) + 8 * i;
#pragma unroll
            for (int e = 0; e < 8; ++e) x[e] = x[e] * r * g[e];
            if (lat) {
#pragma unroll
                for (int e = 0; e < 8; ++e) { const float part = swz_xor<0x101F>(x[e]);     const float2 cs = tab[e]; x[e] = second ? x[e] * cs.x + part * cs.y : x[e] * cs.x - part * cs.y; }
            }
            v4u w; w.x = pk2(x[0], x[1]); w.y = pk2(x[2], x[3]); w.z = pk2(x[4], x[5]); w.w = pk2(x[6], x[7]);
            *p = w;
        }
    }
}

__device__ __forceinline__ void unpack8(const v4u raw, float (&x)[8]) { x[0] = bf_lo(raw.x); x[1] = bf_hi(raw.x); x[2] = bf_lo(raw.y); x[3] = bf_hi(raw.y); x[4] = bf_lo(raw.z); x[5] = bf_hi(raw.z); x[6] = bf_lo(raw.w); x[7] = bf_hi(raw.w); }

__device__ __forceinline__ void glu_phase(Frame& F, int M, const float* cw, const float* cb) {
    PHASE_IDS;
    const int gw = F.vcu * NWAVES + wave, NGW = F.G * NWAVES;
    const bf16* GV = (const bf16*)(F.ws + WS_GV); bf16* U = (bf16*)(F.ws + WS_U);
    const int NU = (M / 16) * (DFF / 512);
    for (int u = gw; u < NU; u += NGW) {
        const int strip = u / (DFF / 512), ch = u % (DFF / 512), r0 = strip * 16, c0 = ch * 512 + lane * 8;
        float w0[8], w1[8], w2[8], bb[8];
#pragma unroll
        for (int e = 0; e < 8; ++e) { w0[e] = cw[c0 + e]; w1[e] = cw[DFF + c0 + e]; w2[e] = cw[2 * DFF + c0 + e]; bb[e] = cb[c0 + e]; }
        const bool hasp = (r0 != 0 && r0 != SEQ), hasn = (r0 + 16 != SEQ && r0 + 16 != M);
        float gp[8], gc[8], gn[8], vv[8];
        const bf16* gbase = GV + (size_t)r0 * NUP + c0;
        if (hasp) unpack8(*(const v4u*)(gbase - NUP), gp); else {
#pragma unroll
            for (int e = 0; e < 8; ++e) gp[e] = 0.f; }
        unpack8(*(const v4u*)gbase, gc);
#pragma unroll 4
        for (int r = 0; r < 16; ++r) {
            const bf16* grow = gbase + (size_t)r * NUP;
            if (r < 15 || hasn) unpack8(*(const v4u*)(grow + NUP), gn); else {
#pragma unroll
                for (int e = 0; e < 8; ++e) gn[e] = 0.f; }
            unpack8(*(const v4u*)(grow + DFF), vv);
            float o[8];
#pragma unroll
            for (int e = 0; e < 8; ++e) { const float t = w0[e] * gp[e] + w1[e] * gc[e] + w2[e] * gn[e] + bb[e]; o[e] = silu_f(t) * vv[e]; gp[e] = gc[e]; gc[e] = gn[e]; }
            v4u w; w.x = pk2(o[0], o[1]); w.y = pk2(o[2], o[3]); w.z = pk2(o[4], o[5]); w.w = pk2(o[6], o[7]);
            *(v4u*)(U + (size_t)(r0 + r) * DFF + c0) = w;
        }
    }
}

__device__ __forceinline__ void sc_phase(Frame& F, int M, const float* cw) {
    PHASE_IDS;
    const int gw = F.vcu * NWAVES + wave, NGW = F.G * NWAVES;
    const bf16* BCV = (const bf16*)(F.ws + WS_BCV); bf16* Z = (bf16*)(F.ws + WS_Z);
    const int NU = (M / 16) * (DM / 512);
    for (int u = gw; u < NU; u += NGW) {
        const int strip = u / (DM / 512), ch = u % (DM / 512), r0 = strip * 16, c0 = ch * 512 + lane * 8;
        float w0[8], w1[8], w2[8];
#pragma unroll
        for (int e = 0; e < 8; ++e) { w0[e] = cw[c0 + e]; w1[e] = cw[DM + c0 + e]; w2[e] = cw[2 * DM + c0 + e]; }
        const bool hasp = (r0 != 0 && r0 != SEQ), hasn = (r0 + 16 != SEQ && r0 + 16 != M);
        float zp[8], zc[8], zn[8], t0[8], t1[8];
        const bf16* base = BCV + (size_t)r0 * NIN + c0;
        if (hasp) { unpack8(*(const v4u*)(base - NIN + DM), t0); unpack8(*(const v4u*)(base - NIN + 2 * DM), t1);
#pragma unroll
            for (int e = 0; e < 8; ++e) zp[e] = t0[e] * t1[e]; } else {
#pragma unroll
            for (int e = 0; e < 8; ++e) zp[e] = 0.f; }
        unpack8(*(const v4u*)(base + DM), t0); unpack8(*(const v4u*)(base + 2 * DM), t1);
#pragma unroll
        for (int e = 0; e < 8; ++e) zc[e] = t0[e] * t1[e];
#pragma unroll 4
        for (int r = 0; r < 16; ++r) {
            const bf16* row = base + (size_t)r * NIN;
            if (r < 15 || hasn) { unpack8(*(const v4u*)(row + NIN + DM), t0); unpack8(*(const v4u*)(row + NIN + 2 * DM), t1);
#pragma unroll
                for (int e = 0; e < 8; ++e) zn[e] = t0[e] * t1[e]; } else {
#pragma unroll
                for (int e = 0; e < 8; ++e) zn[e] = 0.f; }
            unpack8(*(const v4u*)row, t0);
            float o[8];
#pragma unroll
            for (int e = 0; e < 8; ++e) { o[e] = t0[e] * (w0[e] * zp[e] + w1[e] * zc[e] + w2[e] * zn[e]); zp[e] = zc[e]; zc[e] = zn[e]; }
            v4u w; w.x = pk2(o[0], o[1]); w.y = pk2(o[2], o[3]); w.z = pk2(o[4], o[5]); w.w = pk2(o[6], o[7]);
            *(v4u*)(Z + (size_t)(r0 + r) * DM + c0) = w;
        }
    }
}


typedef short cg_bf16x8 __attribute__((ext_vector_type(8)));
typedef float cg_f32x16 __attribute__((ext_vector_type(16)));
template <int MODE, int KW>
__device__ __forceinline__ void ctx_gemm(Frame& F, const bf16* A, const bf16* Bt, int N, const float* Xi, float* Xo, const float* gate, bf16* HNo, const float* scn, float* rowss, bf16* Oc, int ldo, const float* bias) {
    PHASE_IDS;
    const int r32 = lane & 31, hi = lane >> 5;
    constexpr int K = KW * NWAVES, kw = KW;
    const int ncb = N / 32, nitems = (CTXL / 32) * ncb;
    LAS float* part = (LAS float*)(F.lds + RING_OFF);
    for (int it = F.vcu; it < nitems; it += F.G) {
        const int cb = it / (CTXL / 32), rb = it % (CTXL / 32);
        const bf16* ap = A + (size_t)(rb * 32 + r32) * K + wave * kw + hi * 8;
        const bf16* bp = Bt + (size_t)(cb * 32 + r32) * K + wave * kw + hi * 8;
        cg_f32x16 acc = {0.f, 0.f, 0.f, 0.f, 0.f, 0.f, 0.f, 0.f, 0.f, 0.f, 0.f, 0.f, 0.f, 0.f, 0.f, 0.f};
        constexpr int CH = (KW == 256) ? 16 : 22;
        static_assert(KW % (16 * CH) == 0, "ctx_gemm: chunking");
#pragma unroll 1
        for (int k = 0; k < KW; k += 16 * CH) {
            cg_bf16x8 a[CH], b[CH];
#pragma unroll
            for (int q = 0; q < CH; ++q) { a[q] = *(const cg_bf16x8*)(ap + k + 16 * q); b[q] = *(const cg_bf16x8*)(bp + k + 16 * q); }
            __builtin_amdgcn_sched_barrier(0);
#pragma unroll
            for (int q = 0; q < CH; ++q) acc = __builtin_amdgcn_mfma_f32_32x32x16_bf16(a[q], b[q], acc, 0, 0, 0);
            __builtin_amdgcn_sched_barrier(0);
        }
#pragma unroll
        for (int r = 0; r < 16; ++r) part[(wave * 16 + r) * 64 + lane] = acc[r];
        __syncthreads();
        float oldv[2] = {0.f, 0.f};
#pragma unroll
        for (int h = 0; h < 2; ++h) {
            const int e = tid + h * (NWAVES * 64), r = e >> 6, ln = e & 63;
            float sum = 0.f;
#pragma unroll
            for (int w = 0; w < NWAVES; ++w) sum += part[(w * 16 + r) * 64 + ln];
            const int row = rb * 32 + (r & 3) + 8 * (r >> 2) + 4 * (ln >> 5), col = cb * 32 + (ln & 31);
            if (MODE == 0) {
                const float y = Xi[(size_t)row * DM + col] + gate[col] * sum; Xo[(size_t)row * DM + col] = y;
                if (HNo) { HNo[(size_t)row * DM + col] = (bf16)(pk2(y * (1.f + scn[col]), 0.f) & 0xffffu);
                    float ss = row16_sum(y * y); ss += swz_xor<0x401F>(ss);
                    if ((ln & 31) == 0) oldv[h] = unsafeAtomicAdd(rowss + row, ss); }
            } else { const float rinv = __builtin_amdgcn_rsqf(pg8::ld_acc(rowss + row) * (1.f / DM) + RMS_EPS); const float bsum = (bias[(size_t)1 * N + col] + bias[(size_t)3 * N + col]) + (bias[(size_t)5 * N + col] + bias[(size_t)7 * N + col]);
                Oc[(size_t)row * ldo + col] = (bf16)(pk2(rinv * sum + bsum, 0.f) & 0xffffu); }
        }
        if (MODE == 0) asm volatile("" :: "v"(oldv[0]), "v"(oldv[1]));
        __syncthreads();
    }
}

__device__ __forceinline__ att::BlockRef<att::bf16, att::bf16> att_ref(int L, const att::bf16* QKV, att::bf16* AO, const float* sink) {
    att::BlockRef<att::bf16, att::bf16> r; int hq, row0;
    if (L < 512) { const int qb = L >> 4; hq = L & 15; row0 = qb * 256; r.jlo = qb == 0 ? 0 : 4 * qb - 2; const int jhi = (4 * qb + 6 > SEQ / 64) ? SEQ / 64 : 4 * qb + 6; r.ntb = jhi - r.jlo; }
    else { hq = L - 512; row0 = SEQ; r.jlo = 0; r.ntb = 0; }
    r.P0 = row0;
    r.Q = QKV + (size_t)row0 * NQKV + hq * HDIM; r.K = QKV + DM + (hq >> 2) * HDIM; r.V = QKV + DM + NHKV * HDIM + (hq >> 2) * HDIM; r.O = AO + (size_t)row0 * DM + hq * HDIM;
    r.m0 = sink[hq] * 11.313708498984761f;
    return r;
}
__device__ __forceinline__ void attn_phase(Frame& F, const float* sink, bool with_ctx) {
    const att::bf16* QKV = (const att::bf16*)(F.ws + WS_QKV); att::bf16* AO = (att::bf16*)(F.ws + WS_AO);
    const int NU = 512 + (with_ctx ? 16 : 0);
    int L = F.vcu; if (L >= NU) return;
    att::BlockRef<att::bf16, att::bf16> cur = att_ref(L, QKV, AO, sink);
    att::Seam<att::bf16> S;
    att::causal_swa_prime<att::bf16, att::bf16>(cur, F.ldsg + RING_OFF, S, F.wv);
    for (;;) {
        const bool more = L + F.G < NU; const int Ln = more ? L + F.G : L;
        const att::BlockRef<att::bf16, att::bf16> nxt = more ? att_ref(Ln, QKV, AO, sink) : cur;
        att::causal_swa_block<att::bf16, att::bf16>(cur, nxt, F.ldsg + RING_OFF, S, F.wv);
        if (!more) break;
        cur = nxt; L = Ln;
    }
}

#ifndef DUP_P0
#define DUP_P0 1
#endif
#ifndef DUP_N1
#define DUP_N1 1
#endif
#ifndef DUP_G1
#define DUP_G1 1
#endif
#ifndef DUP_SC
#define DUP_SC 1
#endif
#ifndef DUP_ATT
#define DUP_ATT 1
#endif
#ifndef DUP_N2
#define DUP_N2 1
#endif
#ifndef DUP_UP
#define DUP_UP 1
#endif
#ifndef DUP_GLU
#define DUP_GLU 1
#endif
struct Args { const float* in[18]; float* out; unsigned char* ws; int ph_lo, ph_hi; };
constexpr int N_PHASE_SLOTS = 2 + DEPTH * 6;
__global__ void __launch_bounds__(NWAVES * 64, 2) fwd_kernel(Args args) {
    extern __shared__ __attribute__((aligned(16))) unsigned char lds[];
    Frame F;
    F.lds = (LAS unsigned char*)lds; F.ldsg = (char*)lds;
    F.MISC = (volatile LAS unsigned*)(F.lds + MISC_OFF);
    F.G = gridDim.x; { const int bx = blockIdx.x; F.vcu = (F.G % 8 == 0) ? (bx % 8) * (F.G / 8) + bx / 8 : bx; }
    F.ws = args.ws; F.out = args.out;
    F.wv = __builtin_amdgcn_readfirstlane((int)threadIdx.x >> 6);
    for (int u = threadIdx.x; u < (LDS_BYTES - LDSCTL_OFF) / 4; u += NWAVES * 64) ((LAS unsigned*)(F.lds + LDSCTL_OFF))[u] = 0u;
    __syncthreads();
    if (threadIdx.x == 0) {
#pragma unroll
        for (int i = 0; i < 18; ++i) { const unsigned long long p = (unsigned long long)args.in[i]; LAS unsigned* t = (LAS unsigned*)(F.lds + LDSCTL_OFF + 64) + 2 * i; t[0] = (unsigned)p; t[1] = (unsigned)(p >> 32); }
    }
    __syncthreads();
    const int lo = args.ph_lo, hi = args.ph_hi;
    const bool single = (hi - lo) > 1;
    unsigned* barw = (unsigned*)(F.ws + WS_CTL) + CW_BAR;
    XcdBarrier bar; bar.bar = barw; bar.x = 0; bar.st = nullptr;
    if (single) bar = xcd_barrier_post(barw, F.MISC + 8, threadIdx.x == 0);
#define RUN(k) (lo <= (k) && (k) < hi)
#define GRID_BAR() do { if (single) xcd_barrier(bar, F.wv); } while (0)
    float* mod = (float*)(F.ws + WS_MOD);
    bf16* HN = (bf16*)(F.ws + WS_HN); float* XR = (float*)(F.ws + WS_XR);

    if (RUN(0)) { p0a_phase(F); GRID_BAR(); }
    if (RUN(1)) { for (int rep = 0; rep < DUP_P0; ++rep) { p0b_phase(F); __syncthreads(); } GRID_BAR(); }

    float* rowss_all = (float*)(F.ws + WS_CTL + CTL_ROWSS);
    for (int l = 0; l < DEPTH; ++l) {
        const int pb = 2 + l * 6, j = l >> 1; const bool attn = (l & 1) == 0;
        const bool ctx_g1 = l < 3;
        const bool ctx_on = l < 2;
        const float* mod_l = mod + (size_t)l * 2 * NADA;
        float* rowss_m = rowss_all + (size_t)(2 * l) * MR;
        float* rowss_f = rowss_all + (size_t)(2 * l + 1) * MR;
        if (RUN(pb + 0)) {
            const int N = attn ? NQKV : NIN;
            const bf16* Bt = attn ? (const bf16*)(F.ws + WS_WQKV + j * SZ_WQKV) : (const bf16*)(F.ws + WS_WIN + j * SZ_WIN);
            const float* bias = (const float*)(F.ws + WS_BG1 + (size_t)l * SZ_BG1);
            const int Mg = (attn && ctx_g1) ? MR : SEQ;
            if (!attn && ctx_g1 && ctx_on) ctx_gemm<1, DM / NWAVES>(F, HN + (size_t)HN_CTX0 * DM, Bt, N, nullptr, nullptr, nullptr, nullptr, nullptr, rowss_m + SEQ, (bf16*)(F.ws + WS_R1) + (size_t)SEQ * N, N, bias);
            pg8::Gemm g{HN, Bt, Mg, N, DM, HN_LAT0, 256, SEQ / 256, HN_CTX0}; pg8::StaticOrder S; S.init(Mg, N, F.G, (int)blockIdx.x);
            pg8::EpiBf16 E{(bf16*)(F.ws + WS_R1), N, rowss_m, bias, N, SEQ / 256, 1.f / DM, RMS_EPS};
            for (int rep = 0; rep < DUP_G1; ++rep) pg8::gemm_phase<pg8::EpiBf16, pg8::StaticOrder, true, true>(F.lds + RING_OFF, g, S, E, F.wv);
            GRID_BAR();
        }
        if (attn) {
            if (RUN(pb + 1)) { qkr_phase(F, ctx_g1 ? MR : SEQ, inptr(F, 8) + j * HDIM, inptr(F, 9) + j * HDIM); GRID_BAR(); }
            if (RUN(pb + 2)) { for (int rep = 0; rep < DUP_ATT; ++rep) attn_phase(F, inptr(F, 10) + j * NHQ, ctx_on); GRID_BAR(); }
        } else {
            if (RUN(pb + 1)) { for (int rep = 0; rep < DUP_SC; ++rep) sc_phase(F, ctx_on ? MR : SEQ, inptr(F, 12) + (size_t)j * 3 * DM); GRID_BAR(); }
        }
        if (RUN(pb + 3)) {
            const bf16* A = attn ? (const bf16*)(F.ws + WS_AO) : (const bf16*)(F.ws + WS_Z);
            const bf16* Bt = attn ? (const bf16*)(F.ws + WS_WO + j * SZ_WO) : (const bf16*)(F.ws + WS_WOUT + j * SZ_WO);
            const float* Xl = (l == 0) ? inptr(F, 0) : XR;
            const float* Xc = (l == 0) ? inptr(F, 2) : XR + (size_t)SEQ * DM;
            if (ctx_on) ctx_gemm<0, DM / NWAVES>(F, A + (size_t)SEQ * DM, Bt, DM, Xc, XR + (size_t)SEQ * DM, mod_l + NADA + 2 * DM, HN + (size_t)HN_CTX0 * DM, mod_l + NADA + 4 * DM, rowss_f + SEQ, nullptr, 0, nullptr);
            pg8::Gemm g{A, Bt, SEQ, DM, DM, 0, 256, 1 << 30, 0}; pg8::StaticOrder S; S.init(SEQ, DM, F.G, (int)blockIdx.x);
            pg8::EpiResid E{Xl, XR, DM, mod_l + 2 * DM, HN, mod_l + 4 * DM, rowss_f, HN_LAT0};
            pg8::gemm_phase<pg8::EpiResid, pg8::StaticOrder, true, true>(F.lds + RING_OFF, g, S, E, F.wv);
            GRID_BAR();
        }
        if (RUN(pb + 4)) {
            const int nM = (SEQ + 253) / 254 + (ctx_on ? 1 : 0);
            const float* bias = (const float*)(F.ws + WS_BUP + (size_t)l * SZ_BUP);
            pg8::Gemm g{HN, (const bf16*)(F.ws + WS_WUP + l * SZ_WUP), nM * 256, NUP, DM, 0, 254, (SEQ + 253) / 254, HN_CTX0}; pg8::StaticOrder S; S.init(nM * 256, NUP, F.G, (int)blockIdx.x);
            pg8::EpiGlu E{(bf16*)(F.ws + WS_U), DFF, inptr(F, 15) + (size_t)l * 3 * DFF, inptr(F, 16) + (size_t)l * DFF, DFF, (PG8_LAS pg8::f32x4*)(F.lds + XCH_OFF), (SEQ + 253) / 254, SEQ,
                          rowss_f, bias, NUP, 1.f / DM, RMS_EPS};
            for (int rep = 0; rep < DUP_UP; ++rep) pg8::gemm_phase<pg8::EpiGlu, pg8::StaticOrder, true, true>(F.lds + RING_OFF, g, S, E, F.wv);
            GRID_BAR();
        }
        if (RUN(pb + 5)) {
            const bool last = l == DEPTH - 1;
            const float* mod_n = mod_l + 2 * NADA;
            float* rowss_n = rowss_all + (size_t)(2 * l + 2 < 8 ? 2 * l + 2 : 0) * MR;
            if (ctx_on) ctx_gemm<0, DFF / NWAVES>(F, (const bf16*)(F.ws + WS_U) + (size_t)SEQ * DFF, (const bf16*)(F.ws + WS_WDN + l * SZ_WDN), DM, XR + (size_t)SEQ * DM, XR + (size_t)SEQ * DM, mod_l + NADA + 5 * DM,
                                                  HN + (size_t)HN_CTX0 * DM, mod_n + NADA + DM, rowss_n + SEQ, nullptr, 0, nullptr);
            pg8::Gemm g{(const bf16*)(F.ws + WS_U), (const bf16*)(F.ws + WS_WDN + l * SZ_WDN), SEQ, DM, DFF, 0, 256, 1 << 30, 0}; pg8::StaticOrder S; S.init(SEQ, DM, F.G, (int)blockIdx.x);
            pg8::EpiResid E{XR, last ? F.out : XR, DM, mod_l + 5 * DM, last ? (bf16*)nullptr : HN, last ? mod_l + DM : mod_n + DM, rowss_n, HN_LAT0};
            pg8::gemm_phase<pg8::EpiResid, pg8::StaticOrder, true, true>(F.lds + RING_OFF, g, S, E, F.wv);
            if (!last) GRID_BAR();
        }
    }
#undef RUN
#undef GRID_BAR
}

#ifndef MK_PER_PHASE
#define MK_PER_PHASE 0
#endif
extern "C" void kernel_launch(void* const* d_in, const int* in_sizes, int n_in, void* d_out, int out_size, void* d_ws, size_t ws_size, hipStream_t stream) {
    static int grid = 0;
    if (grid == 0) {
        if (n_in != 18 || in_sizes[0] != SEQ * DM || out_size != SEQ * DM || ws_size < WS_END) { fprintf(stderr, "kernel_launch: unexpected shapes (n_in %d, in0 %d, out %d, ws %zu < %zu?); nothing launched\n", n_in, n_in > 0 ? in_sizes[0] : -1, out_size, ws_size, (size_t)WS_END); grid = -1; return; }
        int dev = 0, cus = 0, per_cu = 0;
        if (hipGetDevice(&dev) != hipSuccess || hipDeviceGetAttribute(&cus, hipDeviceAttributeMultiprocessorCount, dev) != hipSuccess) { fprintf(stderr, "kernel_launch: device query failed\n"); grid = -1; return; }
        if (hipFuncSetAttribute((const void*)fwd_kernel, hipFuncAttributeMaxDynamicSharedMemorySize, LDS_BYTES) != hipSuccess) { fprintf(stderr, "kernel_launch: hipFuncSetAttribute failed\n"); grid = -1; return; }
        if (hipOccupancyMaxActiveBlocksPerMultiprocessor(&per_cu, (const void*)fwd_kernel, NWAVES * 64, LDS_BYTES) != hipSuccess || per_cu < 1)
            fprintf(stderr, "kernel_launch: note: occupancy query reports %d workgroups per CU\n", per_cu);
        (void)hipGetLastError();
        grid = cus;
    }
    if (grid < 0) return;
    if (hipMemsetAsync((char*)d_ws + WS_CTL, 0, CTL_ZERO_BYTES, stream) != hipSuccess) { fprintf(stderr, "kernel_launch: hipMemsetAsync failed\n"); return; }
    Args a{};
    for (int i = 0; i < 18; ++i) a.in[i] = (const float*)d_in[i];
    a.out = (float*)d_out; a.ws = (unsigned char*)d_ws;
#if MK_PER_PHASE
    for (int ph = 0; ph < N_PHASE_SLOTS; ++ph) {
        const int slot = ph < 2 ? -1 : (ph - 2) % 6, l = ph < 2 ? 0 : (ph - 2) / 6;
        if (slot == 2 && (l & 1)) continue;
        a.ph_lo = ph; a.ph_hi = ph + 1;
        hipLaunchKernelGGL(fwd_kernel, dim3(grid), dim3(NWAVES * 64), LDS_BYTES, stream, a);
    }
#else
    a.ph_lo = 0; a.ph_hi = N_PHASE_SLOTS;
    hipLaunchKernelGGL(fwd_kernel, dim3(grid), dim3(NWAVES * 64), LDS_BYTES, stream, a);
#endif
    const hipError_t le = hipPeekAtLastError();
    if (le != hipSuccess) fprintf(stderr, "kernel_launch: launch failed: %s\n", hipGetErrorName(le));
}
```

```cpp
#include <hip/hip_runtime.h>
#include <hip/hip_bf16.h>
#include <cstdio>
#include <cstdint>

__device__ __forceinline__ int hw_lane() { int l; asm volatile("v_mbcnt_lo_u32_b32 %0, -1, 0\n\tv_mbcnt_hi_u32_b32 %0, -1, %0" : "=v"(l)); return l; }

namespace pg8 {
#define PG8_LAS __attribute__((address_space(3)))
typedef unsigned short bf16_t;
typedef short bf16x8 __attribute__((ext_vector_type(8)));
typedef float f32x4 __attribute__((ext_vector_type(4)));
typedef unsigned u32x4 __attribute__((ext_vector_type(4)));
constexpr int BM = 256, BK = 64, HALF = 128, HTB = HALF * BK * 2  , STAGE_BYTES = 8 * HTB, NXCD = 8, WGM = 8;

__host__ __device__ __forceinline__ int lds_byte(int r, int c) { const int st = (r >> 4) * 2 + (c >> 5), rr = r & 15, cc = c & 31, ob = rr * 64 + cc * 2; return st * 1024 + (ob ^ (((ob >> 9) & 1) << 5)); }
__host__ __device__ __forceinline__ void stage_rc(int b, int& R, int& C) { const int st = b / 1024, sb = b % 1024, swz = sb ^ (((sb >> 9) & 1) << 5); R = (st >> 1) * 16 + swz / 64; C = (st & 1) * 32 + (swz % 64) / 2; }
__host__ __device__ __forceinline__ int perm32(int rho) { const int n = rho >> 4, i = rho & 15; return 8 * (i >> 2) + 4 * n + (i & 3); }

struct Unit { int pm, pn; };
struct Gemm { const bf16_t* A; const bf16_t* Bt; int M, N, K;
    int a_row0, a_rstride, ctx_pm, ctx_row;
    __host__ __device__ __forceinline__ size_t arow(int pm) const { return pm >= ctx_pm ? (size_t)ctx_row : (size_t)(a_row0 + pm * a_rstride); } };

struct StaticOrder {
    int nM, nN, nwg, G, c;
    __host__ __device__ void init(int M, int N, int G_, int c_) { nM = M / BM; nN = N / BM; nwg = nM * nN; G = G_; c = c_; }
    __host__ __device__ bool next(int i, Unit& u) const {
        const long L = (long)i * G + c; if (L >= nwg) return false;
        int wgid = (int)L; { const int q = nwg / NXCD, r = nwg % NXCD, xcd = wgid % NXCD, off = wgid / NXCD; wgid = (xcd < r ? xcd * (q + 1) : r * (q + 1) + (xcd - r) * q) + off; }
        const int nig = WGM * nN, gid = wgid / nig, fm = gid * WGM, gsz = (nM - fm) < WGM ? (nM - fm) : WGM;
        u.pm = fm + ((wgid % nig) % gsz); u.pn = (wgid % nig) / gsz; return true;
    }
    __device__ __forceinline__ void a_ready(const Unit&) const {}
    __device__ __forceinline__ void done(const Unit&) const {}
};

__device__ __forceinline__ unsigned cvt_pk_bf16(float lo, float hi) { unsigned r; asm volatile("v_cvt_pk_bf16_f32 %0, %1, %2" : "=v"(r) : "v"(lo), "v"(hi)); return r; }

template <int CTRL> __device__ __forceinline__ float dpp_mov(float v) { return __int_as_float(__builtin_amdgcn_mov_dpp(__float_as_int(v), CTRL, 0xF, 0xF, true)); }
__device__ __forceinline__ float fq_sum(float v) {
    v += __int_as_float(__builtin_amdgcn_ds_swizzle(__float_as_int(v), 0x401F));
    const auto rr = __builtin_amdgcn_permlane32_swap(__float_as_uint(v), __float_as_uint(v), false, false);
    return __uint_as_float(rr[0]) + __uint_as_float(rr[1]);
}
__device__ __forceinline__ float ld_acc(const float* p) { return __uint_as_float(__hip_atomic_load((const unsigned*)p, __ATOMIC_RELAXED, __HIP_MEMORY_SCOPE_AGENT)); }
__device__ __forceinline__ f32x4 ld_bias4(const float* b, int nb, int stream, int col) { const float* p = b + (size_t)stream * nb + col; const size_t q = (size_t)2 * nb;
    return (*(const f32x4*)p + *(const f32x4*)(p + q)) + (*(const f32x4*)(p + 2 * q) + *(const f32x4*)(p + 3 * q)); }
struct EpiBf16 {
    static constexpr bool PERM = true, AFTER_DRAIN = false;
    bf16_t* O; int ldc; const float* rowss; const float* bias; int nb; int pm_ctx; float inv_k, eps;
    __device__ __forceinline__ void operator()(f32x4 (&acc)[2][2][4][2], const Unit& u, int wr, int wc, int fr, int fq) const {
        const int row0 = u.pm * BM + wr * 64 + fr, col0 = u.pn * BM + wc * 32 + 8 * fq;
        const int stream = (u.pm >= pm_ctx) ? 1 : 0;
        float rs[8];
#pragma unroll
        for (int i = 0; i < 8; ++i) rs[i] = ld_acc(rowss + row0 + (i >> 2) * HALF + (i & 3) * 16);
        f32x4 bv[2][2];
#pragma unroll
        for (int bj = 0; bj < 2; ++bj)
#pragma unroll
            for (int n = 0; n < 2; ++n) bv[bj][n] = (f32x4){0.f, 0.f, 0.f, 0.f};
        { f32x4 bp[4][2][2];
#pragma unroll
          for (int q = 0; q < 4; ++q)
#pragma unroll
            for (int bj = 0; bj < 2; ++bj)
#pragma unroll
                for (int n = 0; n < 2; ++n) bp[q][bj][n] = *(const f32x4*)(bias + (size_t)(2 * q + stream) * nb + col0 + bj * HALF + 4 * n);
          asm volatile("" ::: "memory");
#pragma unroll
          for (int bj = 0; bj < 2; ++bj)
#pragma unroll
            for (int n = 0; n < 2; ++n) bv[bj][n] = (bp[0][bj][n] + bp[1][bj][n]) + (bp[2][bj][n] + bp[3][bj][n]); }
#pragma unroll
        for (int ai = 0; ai < 2; ++ai)
#pragma unroll
            for (int m = 0; m < 4; ++m) { const int row = row0 + ai * HALF + m * 16; const float r = __builtin_amdgcn_rsqf(rs[ai * 4 + m] * inv_k + eps);
                bf16_t* rowp = O + (size_t)row * ldc + col0;
#pragma unroll
                for (int bj = 0; bj < 2; ++bj) { const f32x4 v0 = acc[ai][bj][m][0] * r + bv[bj][0], v1 = acc[ai][bj][m][1] * r + bv[bj][1];
                    u32x4 w; w.x = cvt_pk_bf16(v0[0], v0[1]); w.y = cvt_pk_bf16(v0[2], v0[3]); w.z = cvt_pk_bf16(v1[0], v1[1]); w.w = cvt_pk_bf16(v1[2], v1[3]);
                    *(u32x4*)(rowp + bj * HALF) = w; } }
    }
};
struct EpiResid {
    static constexpr bool PERM = false, AFTER_DRAIN = false;
    const float* X; float* Y; int ldc; const float* gate; bf16_t* HNo; const float* scn; float* rowss; int hn_row0;
    __device__ __forceinline__ void operator()(f32x4 (&acc)[2][2][4][2], const Unit& u, int wr, int wc, int fr, int fq) const {
        const int row0 = u.pm * BM + wr * 64 + fr, col0 = u.pn * BM + wc * 32 + 4 * fq;
        f32x4 gv[2][2], sv[2][2]; float ssq[8];
#pragma unroll
        for (int bj = 0; bj < 2; ++bj)
#pragma unroll
            for (int n = 0; n < 2; ++n) { gv[bj][n] = *(const f32x4*)(gate + col0 + bj * HALF + n * 16); sv[bj][n] = *(const f32x4*)(scn + col0 + bj * HALF + n * 16) + 1.f; }
#pragma unroll
        for (int ai = 0; ai < 2; ++ai)
#pragma unroll
            for (int mp = 0; mp < 2; ++mp) {
                f32x4 xv[2][2][2];
#pragma unroll
                for (int mm = 0; mm < 2; ++mm)
#pragma unroll
                    for (int bj = 0; bj < 2; ++bj)
#pragma unroll
                        for (int n = 0; n < 2; ++n) xv[mm][bj][n] = *(const f32x4*)(X + (size_t)(row0 + ai * HALF + (2 * mp + mm) * 16) * ldc + col0 + bj * HALF + n * 16);
                asm volatile("" ::: "memory");
#pragma unroll
                for (int mm = 0; mm < 2; ++mm) { const int m = 2 * mp + mm; const int row = row0 + ai * HALF + m * 16; const size_t off = (size_t)row * ldc + col0; float ss = 0.f;
#pragma unroll
                    for (int bj = 0; bj < 2; ++bj)
#pragma unroll
                        for (int n = 0; n < 2; ++n) { const f32x4 y = xv[mm][bj][n] + gv[bj][n] * acc[ai][bj][m][n];
                            *(f32x4*)(Y + off + bj * HALF + n * 16) = y;
                            if (HNo) { ss += (y[0] * y[0] + y[1] * y[1]) + (y[2] * y[2] + y[3] * y[3]); const f32x4 a = y * sv[bj][n];
                                typedef unsigned u32x2v __attribute__((ext_vector_type(2))); u32x2v w; w.x = cvt_pk_bf16(a[0], a[1]); w.y = cvt_pk_bf16(a[2], a[3]);
                                *(u32x2v*)(HNo + (size_t)(hn_row0 + row) * ldc + col0 + bj * HALF + n * 16) = w; } }
                    ssq[ai * 4 + m] = HNo ? fq_sum(ss) : 0.f; }
                asm volatile("" ::: "memory");
            }
        if (HNo && fq == 0) {
#pragma unroll
            for (int i = 0; i < 8; ++i) unsafeAtomicAdd(rowss + row0 + (i >> 2) * HALF + (i & 3) * 16, ssq[i]);
        }
    }
};

struct EpiGlu {
    static constexpr bool PERM = true, AFTER_DRAIN = false;
    bf16_t* U; int ldu; const float* cw; const float* cb; int dff; PG8_LAS f32x4* xch; int ctx_pm, seq;
    const float* rowss; const float* bias; int nb; float inv_k, eps;
    static __device__ __forceinline__ int xi(int ci, int which, int wc, int n, int fq) { return (((ci * 2 + which) * 4 + wc) * 2 + n) * 4 + fq; }
    __device__ __forceinline__ void operator()(f32x4 (&acc)[2][2][4][2], const Unit& u, int wr, int wc, int fr_, int fq_) const {
        int t_ = hw_lane(); asm volatile("" : "+v"(t_)); const int fr = t_ & 15, fq = (t_ >> 4) & 3; (void)fr_; (void)fq_;
        const int ch0 = u.pn * 128 + wc * 32 + 8 * fq;
        const bool is_ctx = u.pm >= ctx_pm;
        { const int stream = is_ctx ? 1 : 0; f32x4 bg[2], bv[2];
#pragma unroll
            for (int n = 0; n < 2; ++n) { bg[n] = ld_bias4(bias, nb, stream, ch0 + 4 * n); bv[n] = ld_bias4(bias, nb, stream, dff + ch0 + 4 * n); }
            float rs[8];
#pragma unroll
            for (int i = 0; i < 8; ++i) { const int R = 128 * (i >> 2) + 64 * wr + 16 * (i & 3) + fr; const int trow = is_ctx ? seq + R : 254 * u.pm - 1 + R;
                rs[i] = ld_acc(rowss + (is_ctx ? trow : (trow < 0 ? 0 : (trow >= seq ? seq - 1 : trow)))); }
#pragma unroll
            for (int ai = 0; ai < 2; ++ai)
#pragma unroll
                for (int m = 0; m < 4; ++m) { const int R = 128 * ai + 64 * wr + 16 * m + fr; const int trow = is_ctx ? seq + R : 254 * u.pm - 1 + R;
                    const bool valid = is_ctx || (trow >= 0 && trow < seq);
                    const float r = valid ? __builtin_amdgcn_rsqf(rs[ai * 4 + m] * inv_k + eps) : 0.f;
#pragma unroll
                    for (int n = 0; n < 2; ++n) { const f32x4 g = acc[ai][0][m][n] * r + bg[n]; acc[ai][0][m][n] = valid ? g : (f32x4){0.f, 0.f, 0.f, 0.f}; acc[ai][1][m][n] = acc[ai][1][m][n] * r + bv[n]; } } }
#pragma unroll
        for (int ai = 0; ai < 2; ++ai) { const int ci = 2 * ai + wr;
            if (fr == 0) {
#pragma unroll
                for (int n = 0; n < 2; ++n) xch[xi(ci, 0, wc, n, fq)] = acc[ai][0][0][n]; }
            if (fr == 15) {
#pragma unroll
                for (int n = 0; n < 2; ++n) xch[xi(ci, 1, wc, n, fq)] = acc[ai][0][3][n]; } }
        asm volatile("s_waitcnt lgkmcnt(0)" ::: "memory"); __builtin_amdgcn_s_barrier(); asm volatile("" ::: "memory");
        f32x4 w0[2], w1[2], w2[2], bb[2];
#pragma unroll
        for (int n = 0; n < 2; ++n) { w0[n] = *(const f32x4*)(cw + ch0 + 4 * n); w1[n] = *(const f32x4*)(cw + dff + ch0 + 4 * n); w2[n] = *(const f32x4*)(cw + 2 * dff + ch0 + 4 * n); bb[n] = *(const f32x4*)(cb + ch0 + 4 * n); }
        const bool l15 = fr == 15, l0 = fr == 0;
#pragma unroll
        for (int ai = 0; ai < 2; ++ai) { const int ci = 2 * ai + wr;
            f32x4 up[2], dn[2];
#pragma unroll
            for (int n = 0; n < 2; ++n) { up[n] = (f32x4){0.f, 0.f, 0.f, 0.f}; dn[n] = (f32x4){0.f, 0.f, 0.f, 0.f};
                if (ci > 0) up[n] = xch[xi(ci - 1, 1, wc, n, fq)];
                if (ci < 3) dn[n] = xch[xi(ci + 1, 0, wc, n, fq)]; }
#pragma unroll
            for (int m = 0; m < 4; ++m) {
                const int R = 128 * ai + 64 * wr + 16 * m + fr;
                float o[8];
#pragma unroll
                for (int n = 0; n < 2; ++n)
#pragma unroll
                    for (int e = 0; e < 4; ++e) {
                        const float x = acc[ai][0][m][n][e];
                        const float xm1 = m > 0 ? acc[ai][0][m > 0 ? m - 1 : 0][n][e] : up[n][e];
                        const float xp1 = m < 3 ? acc[ai][0][m < 3 ? m + 1 : 3][n][e] : dn[n][e];
                        const float gu = dpp_mov<0x121>(l15 ? xm1 : x);
                        const float gd = dpp_mov<0x12F>(l0 ? xp1 : x);
                        const float t = w0[n][e] * gu + w1[n][e] * x + w2[n][e] * gd + bb[n][e];
                        o[4 * n + e] = t * __builtin_amdgcn_rcpf(1.f + __expf(-t)) * acc[ai][1][m][n][e];
                    }
                u32x4 w; w.x = cvt_pk_bf16(o[0], o[1]); w.y = cvt_pk_bf16(o[2], o[3]); w.z = cvt_pk_bf16(o[4], o[5]); w.w = cvt_pk_bf16(o[6], o[7]);
                int grow; bool ok;
                if (is_ctx) { grow = seq + R; ok = true; } else { grow = 254 * u.pm - 1 + R; ok = (R >= 1) && (R <= 254) && (grow < seq); }
                if (ok) *(u32x4*)(U + (size_t)grow * ldu + ch0) = w;
            }
        }
    }
};
template <class Epi, class Sched, bool ALIGN_EPI = false, bool SP2 = false>
__device__ __forceinline__ void gemm_phase(PG8_LAS unsigned char* lds, const Gemm g, const Sched& S, const Epi& E, const int wv  ) {
    int tid_ = (wv << 6) | hw_lane(); asm volatile("" : "+v"(tid_));
    const int tid = tid_, wid = __builtin_amdgcn_readfirstlane(tid >> 6), lane = tid & 63, wr = wid >> 2, wc = wid & 3, fr = lane & 15, fq = lane >> 4;
    const int K = g.K, nt = K / BK;
    unsigned voffA[2], voffB[2];
#pragma unroll
    for (int i = 0; i < 2; ++i) { int R, C; stage_rc(tid * 16 + i * 8192, R, C); const int Rb = Epi::PERM ? ((R & ~31) + perm32(R & 31)) : R;
        voffA[i] = (unsigned)(R * K + C) * 2u; voffB[i] = (unsigned)(Rb * K + C) * 2u; }
    const size_t kstep = (size_t)(BK * 2);
    const size_t hstep = (size_t)HALF * K * 2;
    const size_t tstep = 2 * hstep;
    const unsigned ldsw = (unsigned)wid * 1024u;
    const int aoff = lds_byte(wr * 64 + fr, fq * 8), boff = lds_byte(wc * 32 + fr, fq * 8);
#define PG8_SA(b, h) (((b) * 2 + (h)) * HTB)
#define PG8_SB(b, h) ((4 + (b) * 2 + (h)) * HTB)
#define PG8_STAGE(bufoff, gbase, voff) do { _Pragma("unroll") for (int _i = 0; _i < 2; ++_i) \
        __builtin_amdgcn_global_load_lds((const unsigned*)((const char*)(gbase) + (voff)[_i]), (PG8_LAS unsigned*)(lds + (bufoff) + ldsw + _i * 8192), 16, 0, 0); } while (0)
#define PG8_LDA(dst, b, h) do { _Pragma("unroll") for (int m = 0; m < 4; ++m) _Pragma("unroll") for (int k = 0; k < 2; ++k) dst[m][k] = *(const PG8_LAS bf16x8*)(lds + PG8_SA(b, h) + aoff + m * 2048 + k * 1024); } while (0)
#define PG8_LDB(dst, b, h) do { _Pragma("unroll") for (int n = 0; n < 2; ++n) _Pragma("unroll") for (int k = 0; k < 2; ++k) dst[n][k] = *(const PG8_LAS bf16x8*)(lds + PG8_SB(b, h) + boff + n * 2048 + k * 1024); } while (0)
#define PG8_MMA(ai, bj, At, Bt) do { __builtin_amdgcn_s_setprio(1); _Pragma("unroll") for (int m = 0; m < 4; ++m) _Pragma("unroll") for (int n = 0; n < 2; ++n) _Pragma("unroll") for (int k = 0; k < 2; ++k) \
        acc[ai][bj][m][n] = __builtin_amdgcn_mfma_f32_16x16x32_bf16(Bt[n][k], At[m][k], acc[ai][bj][m][n], 0, 0, 0); __builtin_amdgcn_s_setprio(0); } while (0)
#define PG8_WAIT_V(n) asm volatile("s_waitcnt vmcnt(" #n ")" ::: "memory")
#define PG8_WAIT_L(n) asm volatile("s_waitcnt lgkmcnt(" #n ")" ::: "memory")
#define PG8_BAR __builtin_amdgcn_s_barrier()
#define PG8_SCHED __builtin_amdgcn_sched_barrier(0)
    Unit cur, nxt; int ui = 0;
    if (!S.next(0, cur)) return;
    f32x4 acc[2][2][4][2];
#pragma unroll
    for (int a = 0; a < 2; ++a)
#pragma unroll
        for (int b = 0; b < 2; ++b)
#pragma unroll
            for (int m = 0; m < 4; ++m)
#pragma unroll
                for (int n = 0; n < 2; ++n) acc[a][b][m][n] = (f32x4){0.f, 0.f, 0.f, 0.f};
    bf16x8 At[4][2], B0[2][2], B1[2][2];
    const size_t rstepA = (size_t)K * 2;
    const char* cA = (const char*)g.A + g.arow(cur.pm) * rstepA; const char* cB = (const char*)g.Bt + (size_t)cur.pn * tstep;
    S.a_ready(cur);
    if constexpr (SP2) {
        PG8_STAGE(PG8_SB(0, 0), cB, voffB); PG8_STAGE(PG8_SB(0, 1), cB + hstep, voffB); PG8_STAGE(PG8_SA(0, 0), cA, voffA); PG8_STAGE(PG8_SA(0, 1), cA + hstep, voffA);
        if (wr == 1) PG8_BAR;
        PG8_WAIT_V(2); PG8_BAR;
        PG8_STAGE(PG8_SB(1, 0), cB + kstep, voffB); PG8_STAGE(PG8_SA(1, 0), cA + kstep, voffA); PG8_STAGE(PG8_SB(1, 1), cB + hstep + kstep, voffB);
        PG8_WAIT_V(6); PG8_BAR;
    } else {
        PG8_STAGE(PG8_SB(0, 0), cB, voffB); PG8_STAGE(PG8_SA(0, 0), cA, voffA); PG8_STAGE(PG8_SB(0, 1), cB + hstep, voffB); PG8_STAGE(PG8_SA(0, 1), cA + hstep, voffA);
        if (wr == 1) PG8_BAR;
        PG8_WAIT_V(4); PG8_BAR;
        PG8_STAGE(PG8_SB(1, 0), cB + kstep, voffB); PG8_STAGE(PG8_SA(1, 0), cA + kstep, voffA); PG8_STAGE(PG8_SB(1, 1), cB + hstep + kstep, voffB);
        PG8_WAIT_V(6); PG8_BAR;
    }
    for (;;) {
        const bool has_next = S.next(ui + 1, nxt);
        const char* nA = has_next ? (const char*)g.A + g.arow(nxt.pm) * rstepA : cA; const char* nB = has_next ? (const char*)g.Bt + (size_t)nxt.pn * tstep : cB;
        for (int t = 0; t < nt; t += 2) {
            const bool last = (t == nt - 2);
            const char* a1 = cA + (size_t)(t + 1) * kstep;
            const char* a2 = last ? nA : cA + (size_t)(t + 2) * kstep; const char* b2 = last ? nB : cB + (size_t)(t + 2) * kstep;
            const char* a3 = a2 + kstep; const char* b3 = b2 + kstep;
            if (last && has_next) S.a_ready(nxt);
            if constexpr (SP2) {
            PG8_LDB(B0, 0, 0); PG8_LDB(B1, 0, 1); PG8_SCHED; PG8_LDA(At, 0, 0); PG8_STAGE(PG8_SA(1, 1), a1 + hstep, voffA);
            PG8_WAIT_V(8); PG8_WAIT_L(0); PG8_BAR; PG8_MMA(0, 0, At, B0); PG8_MMA(0, 1, At, B1); PG8_BAR; PG8_SCHED;
            PG8_LDA(At, 0, 1); PG8_STAGE(PG8_SB(0, 0), b2, voffB); PG8_STAGE(PG8_SB(0, 1), b2 + hstep, voffB); PG8_STAGE(PG8_SA(0, 0), a2, voffA);
            PG8_WAIT_V(8); PG8_WAIT_L(0); PG8_BAR; PG8_MMA(1, 0, At, B0); PG8_MMA(1, 1, At, B1); PG8_BAR; PG8_SCHED;
            PG8_LDB(B0, 1, 0); PG8_LDB(B1, 1, 1); PG8_SCHED; PG8_LDA(At, 1, 0); PG8_STAGE(PG8_SA(0, 1), a2 + hstep, voffA);
            PG8_WAIT_V(8); PG8_WAIT_L(0); PG8_BAR; PG8_MMA(0, 0, At, B0); PG8_MMA(0, 1, At, B1); PG8_BAR; PG8_SCHED;
            PG8_LDA(At, 1, 1); PG8_STAGE(PG8_SB(1, 0), b3, voffB); PG8_STAGE(PG8_SB(1, 1), b3 + hstep, voffB); PG8_STAGE(PG8_SA(1, 0), a3, voffA);
            PG8_WAIT_V(8); PG8_WAIT_L(0); PG8_BAR; PG8_MMA(1, 0, At, B0); PG8_MMA(1, 1, At, B1); PG8_BAR; PG8_SCHED;
            } else {
            PG8_LDB(B0, 0, 0); PG8_SCHED; PG8_LDA(At, 0, 0); PG8_STAGE(PG8_SA(1, 1), a1 + hstep, voffA);
            PG8_WAIT_L(8); PG8_BAR; PG8_WAIT_L(0); PG8_MMA(0, 0, At, B0); PG8_BAR; PG8_SCHED;
            PG8_LDB(B1, 0, 1); PG8_STAGE(PG8_SB(0, 0), b2, voffB);
            PG8_BAR; PG8_WAIT_L(0); PG8_MMA(0, 1, At, B1); PG8_BAR;
            PG8_LDA(At, 0, 1); PG8_STAGE(PG8_SA(0, 0), a2, voffA);
            PG8_BAR; PG8_WAIT_L(0); PG8_MMA(1, 0, At, B0); PG8_BAR; PG8_SCHED;
            PG8_STAGE(PG8_SB(0, 1), b2 + hstep, voffB);
            PG8_WAIT_V(6); PG8_BAR; PG8_MMA(1, 1, At, B1); PG8_BAR;
            PG8_LDB(B0, 1, 0); PG8_SCHED; PG8_LDA(At, 1, 0); PG8_STAGE(PG8_SA(0, 1), a2 + hstep, voffA);
            PG8_WAIT_L(8); PG8_BAR; PG8_WAIT_L(0); PG8_MMA(0, 0, At, B0); PG8_BAR; PG8_SCHED;
            PG8_LDB(B1, 1, 1); PG8_STAGE(PG8_SB(1, 0), b3, voffB);
            PG8_BAR; PG8_WAIT_L(0); PG8_MMA(0, 1, At, B1); PG8_BAR;
            PG8_LDA(At, 1, 1); PG8_STAGE(PG8_SA(1, 0), a3, voffA);
            PG8_BAR; PG8_WAIT_L(0); PG8_MMA(1, 0, At, B0); PG8_BAR; PG8_SCHED;
            PG8_STAGE(PG8_SB(1, 1), b3 + hstep, voffB);
            PG8_WAIT_V(6); PG8_BAR; PG8_MMA(1, 1, At, B1); PG8_BAR;
            }
        }
        if constexpr (ALIGN_EPI) { if (wr == 0) PG8_BAR; }
        if constexpr (!Epi::AFTER_DRAIN) { E(acc, cur, wr, wc, fr, fq); S.done(cur); }
        if (!has_next) break;
#pragma unroll
        for (int a = 0; a < 2; ++a)
#pragma unroll
            for (int b = 0; b < 2; ++b)
#pragma unroll
                for (int m = 0; m < 4; ++m)
#pragma unroll
                    for (int n = 0; n < 2; ++n) acc[a][b][m][n] = (f32x4){0.f, 0.f, 0.f, 0.f};
        cur = nxt; cA = nA; cB = nB; ++ui;
        if constexpr (ALIGN_EPI) { if (wr == 1) PG8_BAR; }
    }
    PG8_WAIT_V(0);
    if constexpr (!ALIGN_EPI) { if (wr == 0) PG8_BAR; }
    PG8_BAR;
    if constexpr (Epi::AFTER_DRAIN) { E.fused(acc, cur, wr, wc, fr, fq, lds, wid, lane); S.done(cur); }
#undef PG8_SA
#undef PG8_SB
#undef PG8_STAGE
#undef PG8_LDA
#undef PG8_LDB
#undef PG8_MMA
#undef PG8_WAIT_V
#undef PG8_WAIT_L
#undef PG8_BAR
#undef PG8_SCHED
}
}
namespace att {
constexpr float SCALE = 0.08838834764831845f;
constexpr float THR = 8.f;
constexpr bool WSKIP = true;
constexpr int D = 128, NW = 8, QBLK = 32, KVBLK = 64, QB = NW * QBLK;
constexpr int SHM_V = KVBLK * D * 2, SHM_K = KVBLK * D * 2;
constexpr int ATT_LDS_BYTES = 2 * SHM_V + 2 * SHM_K + NW * 64 * 4;
constexpr int QS = 3072, KS = 3072, OS = 2048;
constexpr int WIN = 128, CTX_TILES = 4, CTXROW0 = 8192;

using bf16 = __hip_bfloat16;
typedef short bf16x8 __attribute__((ext_vector_type(8)));
typedef short s16x4 __attribute__((ext_vector_type(4)));
typedef float f32x16 __attribute__((ext_vector_type(16)));
typedef float f32x4 __attribute__((ext_vector_type(4)));
typedef unsigned u32x4 __attribute__((ext_vector_type(4)));
template <class A, class Bt> struct same_t { static constexpr bool v = false; };
template <class A> struct same_t<A, A> { static constexpr bool v = true; };

#define KSWZ(row, colB) ((row) * 256 + ((colB) ^ (((row) & 7) << 4)))
#define SBAR() __builtin_amdgcn_sched_barrier(0)
__device__ __forceinline__ int v_st(int k, int c) { const int kk = (k & ~0xC) | ((k & 4) << 1) | ((k & 8) >> 1); return ((kk >> 3) * 4 + (c >> 5)) * 512 + ((kk & 7) * 32 + (c & 31)) * 2; }
__device__ __forceinline__ int v_rd_base(int lane) { return ((lane & 3) << 3) | (((lane >> 2) & 3) << 6) | (((lane >> 4) & 1) << 5) | (((lane >> 5) & 1) << 8); }
constexpr int v_rd_off(int d0, int ks, int half) { return d0 * 512 + ks * 4096 + half * 2048; }
__device__ __forceinline__ int crow(int r, int hi) { return (r & 3) + 8 * (r >> 2) + 4 * hi; }
__device__ __forceinline__ unsigned cvtpk(float lo, float hi) {
    unsigned r; asm volatile("v_cvt_pk_bf16_f32 %0, %1, %2" : "=v"(r) : "v"(lo), "v"(hi)); return r;
}
__device__ __forceinline__ bf16x8 pack8(f32x4 a, f32x4 b) {
    u32x4 w = {cvtpk(a[0], a[1]), cvtpk(a[2], a[3]), cvtpk(b[0], b[1]), cvtpk(b[2], b[3])};
    return *reinterpret_cast<bf16x8*>(&w);
}
template <class T> __device__ __forceinline__ bf16x8 load8(const T* p) {
    if constexpr (same_t<T, float>::v) { return pack8(*(const f32x4*)p, *(const f32x4*)(p + 4)); }
    else { return *reinterpret_cast<const bf16x8*>(p); }
}
__device__ __forceinline__ void mask_tile(f32x16& p0, f32x16& p1, int dq, unsigned W) {
    const float NEG = -__builtin_inff();
#pragma unroll
    for (int r = 0; r < 16; ++r) {
        const int c = (r & 3) + 8 * (r >> 2);
        if ((unsigned)(dq - c) >= W) p0[r] = NEG;
        if ((unsigned)(dq - c - 32) >= W) p1[r] = NEG;
    }
}
__device__ __forceinline__ void partialSM(f32x16& p0, f32x16& p1, float& m_reg, float& mn, float& alpha) {
    float pmax = p0[0]; for (int r = 1; r < 16; ++r) pmax = fmaxf(pmax, p0[r]); for (int r = 0; r < 16; ++r) pmax = fmaxf(pmax, p1[r]);
    { auto rr = __builtin_amdgcn_permlane32_swap(__float_as_uint(pmax), __float_as_uint(pmax), false, false);
      pmax = fmaxf(__uint_as_float(rr[0]), __uint_as_float(rr[1])); }
    constexpr float C2 = 1.4426950408889634f * SCALE;
    if (__builtin_expect(__all((pmax - m_reg) * SCALE <= THR), 1)) { mn = m_reg; alpha = 1.f; }
    else { mn = fmaxf(m_reg, pmax); alpha = __builtin_amdgcn_exp2f((m_reg - mn) * C2); m_reg = mn; }
    const float mnL = -mn * C2;
    for (int r = 0; r < 16; ++r) p0[r] = fmaf(p0[r], C2, mnL); for (int r = 0; r < 16; ++r) p1[r] = fmaf(p1[r], C2, mnL);
    for (int r = 0; r < 16; ++r) p0[r] = __builtin_amdgcn_exp2f(p0[r]);
}
__device__ __forceinline__ void finishSM(f32x16& p0, f32x16& p1, float alpha, float& l_reg, bf16x8& pa0, bf16x8& pa1, bf16x8& pa2, bf16x8& pa3) {
    for (int r = 0; r < 16; ++r) p1[r] = __builtin_amdgcn_exp2f(p1[r]);
    float ps = 0; for (int r = 0; r < 16; ++r) ps += p0[r]; for (int r = 0; r < 16; ++r) ps += p1[r];
    { auto rr = __builtin_amdgcn_permlane32_swap(__float_as_uint(ps), __float_as_uint(ps), false, false);
      ps = __uint_as_float(rr[0]) + __uint_as_float(rr[1]); }
    l_reg = l_reg * alpha + ps;
#define PK4(P, B_, OUT) do { unsigned a0 = cvtpk(P[B_+0], P[B_+1]), a1 = cvtpk(P[B_+2], P[B_+3]);                          \
        unsigned b0 = cvtpk(P[B_+4], P[B_+5]), b1 = cvtpk(P[B_+6], P[B_+7]);                                             \
        auto r0 = __builtin_amdgcn_permlane32_swap(a0, b0, false, false); auto r1 = __builtin_amdgcn_permlane32_swap(a1, b1, false, false); \
        u32x4 w = {r0[0], r1[0], r0[1], r1[1]}; OUT = *reinterpret_cast<bf16x8*>(&w); } while (0)
    PK4(p0, 0, pa0); PK4(p0, 8, pa1); PK4(p1, 0, pa2); PK4(p1, 8, pa3);
#undef PK4
}
template <int KB, bool SK>
__device__ __forceinline__ void qkt(f32x16& p0, f32x16& p1, const char* K_lds, int r32, int hi, const bf16x8* qr, bool act) {
    if (SK && !act) { const float NEG = -__builtin_inff();
#pragma unroll
        for (int r = 0; r < 16; ++r) { p0[r] = NEG; p1[r] = NEG; } return; }
    p0 = f32x16{}; p1 = f32x16{};
    const char* kb[4];
#pragma unroll
    for (int dd = 0; dd < 4; ++dd) kb[dd] = K_lds + KB * SHM_K + KSWZ(r32, (dd * 16 + hi * 8) * 2);
#pragma unroll
    for (int d0 = 0; d0 < 8; ++d0) { const char* a = kb[d0 & 3] + (d0 >> 2) * 128;
        bf16x8 b0 = *reinterpret_cast<const bf16x8*>(a);
        bf16x8 b1 = *reinterpret_cast<const bf16x8*>(a + 32 * 256);
        p0 = __builtin_amdgcn_mfma_f32_32x32x16_bf16(b0, qr[d0], p0, 0, 0, 0);
        p1 = __builtin_amdgcn_mfma_f32_32x32x16_bf16(b1, qr[d0], p1, 0, 0, 0); }
}
template <int VB, bool SK>
__device__ __forceinline__ void pv_tile(f32x16* o, int vb0, bf16x8 pa0, bf16x8 pa1, bf16x8 pa2, bf16x8 pa3, bool act) {
    if (SK && !act) return;
#define TRRD(dst, off) asm volatile("ds_read_b64_tr_b16 %0, %1 offset:%2" : "=&v"(dst) : "v"(vb0), "i"(off) : "memory")
#define PV_D0(d0) do { s16x4 l0, l1, l2, l3, h0, h1, h2, h3; constexpr int b_ = VB * SHM_V + v_rd_off(d0, 0, 0);     \
        TRRD(l0, b_); TRRD(h0, b_ + 2048); TRRD(l1, b_ + 4096); TRRD(h1, b_ + 6144); TRRD(l2, b_ + 8192); TRRD(h2, b_ + 10240); TRRD(l3, b_ + 12288); TRRD(h3, b_ + 14336); \
        asm volatile("s_waitcnt lgkmcnt(0)" ::: "memory"); SBAR();                 \
        o[d0] = __builtin_amdgcn_mfma_f32_32x32x16_bf16(pa0, (bf16x8){l0[0], l0[1], l0[2], l0[3], h0[0], h0[1], h0[2], h0[3]}, o[d0], 0, 0, 0);   \
        o[d0] = __builtin_amdgcn_mfma_f32_32x32x16_bf16(pa1, (bf16x8){l1[0], l1[1], l1[2], l1[3], h1[0], h1[1], h1[2], h1[3]}, o[d0], 0, 0, 0);   \
        o[d0] = __builtin_amdgcn_mfma_f32_32x32x16_bf16(pa2, (bf16x8){l2[0], l2[1], l2[2], l2[3], h2[0], h2[1], h2[2], h2[3]}, o[d0], 0, 0, 0);   \
        o[d0] = __builtin_amdgcn_mfma_f32_32x32x16_bf16(pa3, (bf16x8){l3[0], l3[1], l3[2], l3[3], h3[0], h3[1], h3[2], h3[3]}, o[d0], 0, 0, 0); } while (0)
    PV_D0(0); PV_D0(1); PV_D0(2); PV_D0(3);
#undef PV_D0
#undef TRRD
}

template <class TIn, class TOut> struct BlockRef { const TIn* Q; const TIn* K; const TIn* V; TOut* O; int P0; int jlo, ntb; float m0; };
template <class TIn, class TOut> __device__ __forceinline__ int krow0(const BlockRef<TIn, TOut>& b) { return b.ntb > 0 ? b.jlo * KVBLK : CTXROW0; }
template <class TIn> struct Seam {
    bf16x8 qr[8];
    bf16x8 st_v0, st_v1, st_k0, st_k1; f32x4 sf0, sf1, sf2, sf3;
    f32x4 tq[16];
};
__device__ __forceinline__ int swa_jlo(int P0, int W) { const int lowk = P0 - W + 1; return lowk > 0 ? lowk / KVBLK : 0; }
#define ROW(p, k0, rr) ((p) + (size_t)((k0) + (rr)) * KS + sc)
#define VMW() asm volatile("s_waitcnt vmcnt(0)" ::: "memory")
#define VMWN(n) asm volatile("s_waitcnt vmcnt(%0)" :: "i"(n) : "memory")
#define SLOAD_H(Kp, Vp, k0) do { S.st_v0 = load8<TIn>(ROW(Vp, k0, sr)); S.st_v1 = load8<TIn>(ROW(Vp, k0, 32 + sr));              \
                         S.st_k0 = load8<TIn>(ROW(Kp, k0, sr)); S.st_k1 = load8<TIn>(ROW(Kp, k0, 32 + sr)); } while (0)
#define SWRITE_HK(bf) do { *(bf16x8*)(K_lds + (bf) * SHM_K + kws) = S.st_k0; *(bf16x8*)(K_lds + (bf) * SHM_K + kws + 32 * 256) = S.st_k1; } while (0)
#define SWRITE_HV(bf) do { *(bf16x8*)(V_lds + (bf) * SHM_V + vst0) = S.st_v0; *(bf16x8*)(V_lds + (bf) * SHM_V + vst1) = S.st_v1; } while (0)
#define SWRITE_H(bf) do { SWRITE_HV(bf); SWRITE_HK(bf); } while (0)
#define SLOAD_F(p, k0) do { S.sf0 = *(const f32x4*)ROW(p, k0, sr); S.sf1 = *(const f32x4*)(ROW(p, k0, sr) + 4);                \
                            S.sf2 = *(const f32x4*)ROW(p, k0, 32 + sr); S.sf3 = *(const f32x4*)(ROW(p, k0, 32 + sr) + 4); } while (0)
#define SWRITE_KF(bf) do { *(bf16x8*)(K_lds + (bf) * SHM_K + kws) = pack8(S.sf0, S.sf1); *(bf16x8*)(K_lds + (bf) * SHM_K + kws + 32 * 256) = pack8(S.sf2, S.sf3); } while (0)
#define SWRITE_VF(bf) do { *(bf16x8*)(V_lds + (bf) * SHM_V + vst0) = pack8(S.sf0, S.sf1); *(bf16x8*)(V_lds + (bf) * SHM_V + vst1) = pack8(S.sf2, S.sf3); } while (0)
template <class TIn, class TOut>
__device__ __forceinline__ void causal_swa_prime(const BlockRef<TIn, TOut>& cur, char* lds, Seam<TIn>& S, const int wv) {
    constexpr bool F32 = same_t<TIn, float>::v;
    int tid_ = (wv << 6) | hw_lane(); asm volatile("" : "+v"(tid_));
    const int tid = tid_, wid = __builtin_amdgcn_readfirstlane(tid >> 6), lane = tid & 63, r32 = lane & 31, hi = lane >> 5;
    const int sr = tid >> 4, sc = (tid & 15) * 8, kws = KSWZ(sr, sc * 2); char* K_lds = lds + 2 * SHM_V;
    const int kb0 = krow0(cur);
    for (int d0 = 0; d0 < 8; ++d0) S.qr[d0] = load8<TIn>(cur.Q + (size_t)(wid * QBLK + r32) * QS + d0 * 16 + hi * 8);
    if constexpr (F32) { SLOAD_F((const float*)cur.K, kb0); VMW(); SWRITE_KF(0); SBAR(); SLOAD_F((const float*)cur.V, kb0); }
    else { SLOAD_H(cur.K, cur.V, kb0); VMW(); SWRITE_HK(0); }
    __syncthreads();
}
template <class TIn, class TOut>
__device__ __forceinline__ void causal_swa_block(const BlockRef<TIn, TOut>& cur, const BlockRef<TIn, TOut>& nxt, char* lds, Seam<TIn>& S, const int wv) {
    constexpr bool F32 = same_t<TIn, float>::v;
    int tid_ = (wv << 6) | hw_lane(); asm volatile("" : "+v"(tid_));
    const int tid = tid_, wid = __builtin_amdgcn_readfirstlane(tid >> 6), lane = tid & 63, r32 = lane & 31, hi = lane >> 5;
    const int j_lo = cur.jlo, NTB = cur.ntb;
    const int NT = NTB + CTX_TILES;
    const int kbn = krow0(nxt);
    const int qlo = cur.P0 + wid * QBLK, qm = qlo + r32 - 4 * hi;
    char* V_lds = lds; char* K_lds = lds + 2 * SHM_V;
    float* ws = (float*)(lds + 2 * SHM_V + 2 * SHM_K) + wid * 64; float* li_l = ws, * al_l = ws + 32;
    float m_reg = cur.m0, l_reg = 1.f; f32x16 o[4] = {};
    const int sr = tid >> 4, sc = (tid & 15) * 8, vst0 = v_st(sr, sc), vst1 = v_st(32 + sr, sc), kws = KSWZ(sr, sc * 2);
    const int vb0 = (int)(uintptr_t)V_lds + v_rd_base(lane);
    const TIn* Kh = cur.K; const TIn* Vh = cur.V;
#define RESC(a) do { if (__any((a) < 1.f)) { if (hi == 0) al_l[r32] = (a); asm volatile("s_waitcnt lgkmcnt(0)" ::: "memory");              \
                     for (int d_ = 0; d_ < 4; ++d_) for (int r = 0; r < 16; ++r) o[d_][r] *= al_l[crow(r, hi)]; } } while (0)
#define KBASE(t) ((j_lo + (t)) * KVBLK)
#define KROW(t) (((t) < NTB) ? KBASE(t) : CTXROW0 + ((t) - NTB) * KVBLK)
#define ACT(t) ((t) >= NTB || (KBASE(t) <= qlo + QBLK - 1 + WIN && KBASE(t) + KVBLK - 1 >= qlo - WIN))
#define MASKT(P0_, P1_, t) do { const int kb_ = KBASE(t); if ((t) < NTB && (!SK || ACT(t)) && (kb_ + KVBLK - 1 > qlo + WIN || kb_ < qlo + QBLK - 1 - WIN)) mask_tile(P0_, P1_, qm - kb_ + WIN, (unsigned)(2 * WIN + 1)); } while (0)
    constexpr int NQL = F32 ? 16 : 8;
    constexpr bool SK = WSKIP && !F32;
#define SEAM_K0() do { VMWN(NQL); if constexpr (F32) { SWRITE_KF(0); SBAR(); SLOAD_F((const float*)nxt.V, kbn); } else { SWRITE_HK(0); } SBAR(); } while (0)
    f32x16 pA0, pA1, pB0, pB1; float mnA, mnB, alA, alB; bf16x8 pa0, pa1, pa2, pa3;
    if constexpr (F32) { VMW(); SWRITE_VF(0); SBAR(); } else { SWRITE_HV(0); SBAR(); }
    if (NT > 1) { if constexpr (F32) SLOAD_F((const float*)Kh, KROW(1)); else SLOAD_H(Kh, Vh, KROW(1)); }
    SBAR(); qkt<0, SK>(pA0, pA1, K_lds, r32, hi, S.qr, ACT(0));
    if constexpr (F32) { if (NT > 1) { VMW(); SWRITE_KF(1); SBAR(); SLOAD_F((const float*)Vh, KROW(1)); } }
    MASKT(pA0, pA1, 0); partialSM(pA0, pA1, m_reg, mnA, alA);
    if (NT > 1) { VMW(); if constexpr (F32) { SWRITE_VF(1); SBAR(); if (NT > 2) SLOAD_F((const float*)Kh, KROW(2)); } else SWRITE_H(1); }
    __syncthreads();
#define HALF_STEP(PX0, PX1, mnX, alX, PY0, PY1, alY, t, KB, VB, SB) do {                                                      \
        SBAR(); qkt<KB, SK>(PX0, PX1, K_lds, r32, hi, S.qr, ACT(t));                                             \
        finishSM(PY0, PY1, alY, l_reg, pa0, pa1, pa2, pa3); SBAR();                                                           \
        if ((t) + 1 < NT) { if constexpr (F32) { VMW(); SWRITE_KF(SB); SBAR(); SLOAD_F((const float*)Vh, KROW((t) + 1)); }  \
                            else { SLOAD_H(Kh, Vh, KROW((t) + 1)); } SBAR(); }                                               \
        pv_tile<VB, SK>(o, vb0, pa0, pa1, pa2, pa3, ACT((t) - 1)); MASKT(PX0, PX1, (t)); partialSM(PX0, PX1, m_reg, mnX, alX);                                        \
        __syncthreads();                                                                                                      \
        if ((t) + 1 < NT) { VMW(); if constexpr (F32) { SWRITE_VF(SB); SBAR(); if ((t) + 2 < NT) SLOAD_F((const float*)Kh, KROW((t) + 2)); } \
                            else { SWRITE_H(SB); } }                                                                          \
        RESC(alX); __syncthreads(); } while (0)
    for (int t = 1; t + 1 < NT; t += 2) {
        HALF_STEP(pB0, pB1, mnB, alB, pA0, pA1, alA, t, 1, 0, 0);
        HALF_STEP(pA0, pA1, mnA, alA, pB0, pB1, alB, t + 1, 0, 1, 1);
    }
    const bool even = (NT & 1) == 0;
    if (even) { SBAR(); qkt<1, SK>(pB0, pB1, K_lds, r32, hi, S.qr, ACT(NT - 1)); SBAR(); }
#define QROW(e) (nxt.Q + (size_t)(wid * QBLK + r32) * QS + ((e) >> 1) * 16 + hi * 8 + ((e) & 1) * 4)
    if constexpr (F32) { SLOAD_F((const float*)nxt.K, kbn); SBAR();
#pragma unroll
        for (int e = 0; e < 8; ++e) S.tq[e] = *(const f32x4*)QROW(e); }
    else { SLOAD_H(nxt.K, nxt.V, kbn); SBAR();
#pragma unroll
        for (int d0 = 0; d0 < 8; ++d0) S.qr[d0] = load8<TIn>(nxt.Q + (size_t)(wid * QBLK + r32) * QS + d0 * 16 + hi * 8); }
    SBAR();
    finishSM(pA0, pA1, alA, l_reg, pa0, pa1, pa2, pa3); SBAR();
    if constexpr (F32) {
#pragma unroll
        for (int e = 8; e < 16; ++e) S.tq[e] = *(const f32x4*)QROW(e); SBAR(); }
#undef QROW
    pv_tile<0, SK>(o, vb0, pa0, pa1, pa2, pa3, ACT(even ? NT - 2 : NT - 1));
    if (even) { MASKT(pB0, pB1, NT - 1); partialSM(pB0, pB1, m_reg, mnB, alB); __syncthreads(); RESC(alB);
        finishSM(pB0, pB1, alB, l_reg, pa0, pa1, pa2, pa3); SBAR(); pv_tile<1, SK>(o, vb0, pa0, pa1, pa2, pa3, ACT(NT - 1)); }
    SBAR(); SEAM_K0();
    if (hi == 0) li_l[r32] = l_reg; asm volatile("s_waitcnt lgkmcnt(0)" ::: "memory");
    float rli[16];
#pragma unroll
    for (int r = 0; r < 16; ++r) rli[r] = __builtin_amdgcn_rcpf(li_l[crow(r, hi)]);
    int r32o = r32, hio = hi; asm volatile("" : "+v"(r32o), "+v"(hio));
    char* Owb = (char*)(cur.O + (size_t)(wid * QBLK) * OS);
#pragma unroll
    for (int r = 0; r < 16; ++r) { const unsigned ooff = (unsigned)((crow(r, hio) * OS + r32o) * 2);
#pragma unroll
        for (int d0 = 0; d0 < 4; ++d0) { const float v = o[d0][r] * rli[r];
            if constexpr (same_t<TOut, float>::v) { static_assert(!same_t<TOut, float>::v, "bf16 O only"); }
            else { const float vn = __int_as_float(__builtin_amdgcn_mov_dpp(__float_as_int(v), 0xB1, 0xF, 0xF, true));
                   if ((r32o & 1) == 0) *(unsigned*)(Owb + ooff + d0 * 64) = cvtpk(v, vn); } } }
    if constexpr (F32) {
#pragma unroll
        for (int d0 = 0; d0 < 8; ++d0) S.qr[d0] = pack8(S.tq[2 * d0], S.tq[2 * d0 + 1]); }
    __syncthreads();
#undef RESC
#undef KBASE
#undef KROW
#undef ACT
#undef MASKT
#undef SEAM_K0
#undef HALF_STEP
}
#undef ROW
#undef VMW
#undef VMWN
#undef SLOAD_H
#undef SWRITE_HK
#undef SWRITE_HV
#undef SWRITE_H
#undef SLOAD_F
#undef SWRITE_KF
#undef SWRITE_VF
}
constexpr int DM = 2048, SEQ = 8192, CTXL = 256, MR = SEQ + CTXL, DEPTH = 4, HDIM = 128, NHQ = 16, NHKV = 4;
constexpr int NQKV = 3072, DFF = 5632, NUP = 2 * DFF, NIN = 3 * DM, NADA = 6 * DM;
constexpr float RMS_EPS = 1e-6f;
constexpr int NWAVES = 8;

constexpr size_t MiB = 1u << 20;
constexpr size_t WS_CTL = 0, CTL_ZERO_BYTES = 1 * MiB;
constexpr size_t WS_MOD = 1 * MiB;
constexpr size_t WS_ROPE = WS_MOD + 512 * 1024;
constexpr size_t SZ_WQKV = (size_t)NQKV * DM * 2, SZ_WO = (size_t)DM * DM * 2, SZ_WIN = (size_t)NIN * DM * 2, SZ_WUP = (size_t)NUP * DM * 2, SZ_WDN = (size_t)DM * DFF * 2;
constexpr size_t WS_WQKV = 2 * MiB, WS_WO = WS_WQKV + 2 * SZ_WQKV, WS_WIN = WS_WO + 2 * SZ_WO, WS_WOUT = WS_WIN + 2 * SZ_WIN, WS_WUP = WS_WOUT + 2 * SZ_WO, WS_WDN = WS_WUP + 4 * SZ_WUP;
constexpr size_t WS_XR = WS_WDN + 4 * SZ_WDN;
constexpr size_t WS_HN = WS_XR + (size_t)MR * DM * 4;
constexpr int HN_LAT0 = 1, HN_CTX0 = SEQ + 2;
constexpr size_t WS_R1 = WS_HN + (size_t)(MR + 8) * DM * 2;
constexpr size_t WS_GV = WS_R1, WS_QKV = WS_R1, WS_AO = WS_R1 + (size_t)MR * NQKV * 2, WS_BCV = WS_R1, WS_Z = WS_R1 + (size_t)MR * NIN * 2;
constexpr size_t WS_U = WS_R1 + (size_t)MR * NUP * 2;
constexpr size_t WS_BG1 = WS_U + (size_t)MR * DFF * 2, SZ_BG1 = (size_t)4 * 2 * NIN * 4, WS_BUP = WS_BG1 + DEPTH * SZ_BG1, SZ_BUP = (size_t)4 * 2 * NUP * 4;
constexpr size_t WS_END = WS_BUP + DEPTH * SZ_BUP;
constexpr int CW_BAR = 4096;
constexpr size_t CTL_ROWSS = 64 * 1024;
static_assert(CTL_ROWSS + (size_t)8 * MR * 4 <= CTL_ZERO_BYTES, "CTL map");

constexpr int RING_OFF = 0, RING_BYTES = 131072;
constexpr int LDSCTL_OFF = RING_BYTES, MISC_OFF = LDSCTL_OFF + 320;
constexpr int XCH_OFF = MISC_OFF + 128, XCH_BYTES = 4096;
constexpr int LDS_BYTES = 147456;
static_assert(XCH_OFF % 16 == 0 && XCH_OFF + XCH_BYTES <= LDS_BYTES, "LDS map");

#define GAS __attribute__((address_space(1)))
#define LAS __attribute__((address_space(3)))
typedef unsigned short bf16;
typedef unsigned v4u __attribute__((ext_vector_type(4)));
typedef unsigned v2u __attribute__((ext_vector_type(2)));
typedef float f32x4 __attribute__((ext_vector_type(4)));
typedef GAS unsigned gu32;
#define RLX_AGENT __ATOMIC_RELAXED, __HIP_MEMORY_SCOPE_AGENT
#define LDS_WAIT() asm volatile("s_waitcnt lgkmcnt(0)" ::: "memory")
__device__ __forceinline__ unsigned pk2(float lo, float hi) { return pg8::cvt_pk_bf16(lo, hi); }
__device__ __forceinline__ float bf_lo(unsigned w) { return __uint_as_float(w << 16); }
__device__ __forceinline__ float bf_hi(unsigned w) { return __uint_as_float(w & 0xffff0000u); }

#define XB_TMO      128
#define XB_XCNT(j)  (256  + 64 * (j))
#define XB_XSUB(j)  (1280 + 64 * (j))
#define XB_XGEN(j)  (2304 + 64 * (j))
#define XB_TOP      3328
#define XB_TOPGEN   3392
#define XCD_BAR_WORDS 3456
#define XB_SPIN_CAP (1u << 18)

__device__ __forceinline__ unsigned xb_ld(unsigned* p)              { return __hip_atomic_load(p, __ATOMIC_RELAXED, __HIP_MEMORY_SCOPE_AGENT); }
__device__ __forceinline__ unsigned xb_add(unsigned* p, unsigned v) { return __hip_atomic_fetch_add(p, v, __ATOMIC_RELAXED, __HIP_MEMORY_SCOPE_AGENT); }
__device__ __forceinline__ unsigned xb_xcc_id() { return (unsigned)__builtin_amdgcn_s_getreg((3 << 11) | 20) & 0xFu; }
#define XB_SPIN(cond, bar) do { unsigned _sp = 0; while (cond) { __builtin_amdgcn_s_sleep(1); \
    if ((++_sp & 255u) == 0u) { if (xb_ld(&(bar)[XB_TMO])) break; if (_sp > XB_SPIN_CAP) { atomicAdd(&(bar)[XB_TMO], 1u); break; } } } } while (0)

struct XcdBarrier {
    unsigned* bar; unsigned x;
    volatile LAS unsigned* st;
};
__device__ __forceinline__ XcdBarrier xcd_barrier_post(unsigned* bar, volatile LAS unsigned* st, const bool t0  ) {
    XcdBarrier b; b.bar = bar; b.x = xb_xcc_id(); b.st = st;
    if (t0) (void)xb_add(&bar[XB_XCNT(b.x)], 1u);
    return b;
}
__device__ __forceinline__ void xcd_barrier_complete(unsigned* bar, unsigned x, unsigned& nloc, unsigned& nx) {
    const unsigned G = gridDim.x * gridDim.y * gridDim.z;
    unsigned sum, cnt, mine, sp = 0u;
    for (;;) {
        sum = 0u; cnt = 0u; mine = 0u;
#pragma unroll
        for (unsigned j = 0; j < 16; ++j) { const unsigned c = xb_ld(&bar[XB_XCNT(j)]); sum += c; cnt += (c > 0u) ? 1u : 0u; mine = (j == x) ? c : mine; }
        if (sum == G) break;
        __builtin_amdgcn_s_sleep(1);
        if ((++sp & 255u) == 0u) { if (xb_ld(&bar[XB_TMO])) break; if (sp > XB_SPIN_CAP) { atomicAdd(&bar[XB_TMO], 1u); break; } }
    }
    nloc = mine > 0u ? mine : 1u; nx = cnt > 0u ? cnt : 1u;
}
__device__ __forceinline__ void xcd_barrier(const XcdBarrier& b, const int wv) {
    asm volatile("s_waitcnt vmcnt(0)" ::: "memory");
    __syncthreads();
    if (wv == 0 && hw_lane() == 0) {
        unsigned long long bar_i = (unsigned long long)b.bar; asm volatile("" : "+s"(bar_i));
        unsigned* bar = (unsigned*)(GAS unsigned*)bar_i;
        __builtin_amdgcn_s_waitcnt(0);
        unsigned nloc = b.st[0], nx = b.st[1];
        if (nloc == 0u) { xcd_barrier_complete(bar, b.x, nloc, nx); b.st[0] = nloc; b.st[1] = nx; }
        const unsigned old = xb_add(&bar[XB_XSUB(b.x)], 1u);
        const unsigned gen = old / nloc;
        if (old + 1u == (gen + 1u) * nloc) {
            __builtin_amdgcn_fence(__ATOMIC_RELEASE, "agent");
            asm volatile("s_waitcnt vmcnt(0)" ::: "memory");
            const unsigned og = xb_add(&bar[XB_TOP], 1u);
            const unsigned tg = og / nx;
            if (og + 1u == (tg + 1u) * nx) xb_add(&bar[XB_TOPGEN], 1u);
            else XB_SPIN(xb_ld(&bar[XB_TOPGEN]) == tg, bar);
            __builtin_amdgcn_fence(__ATOMIC_ACQUIRE, "agent");
            xb_add(&bar[XB_XGEN(b.x)], 1u);
            asm volatile("s_waitcnt vmcnt(0)" ::: "memory");
        } else {
            XB_SPIN(xb_ld(&bar[XB_XGEN(b.x)]) == gen, bar);
            __builtin_amdgcn_fence(__ATOMIC_ACQUIRE, "agent");
            asm volatile("s_waitcnt vmcnt(0)" ::: "memory");
        }
    }
    __syncthreads();
}

struct Frame {
    LAS unsigned char* lds; char* ldsg;
    volatile LAS unsigned* MISC;
    unsigned char* ws;
    int vcu, G;
    int wv;
    float* out;
};
__device__ __forceinline__ const float* inptr(const Frame& F, int i) {
    const LAS unsigned* t = (const LAS unsigned*)(F.lds + LDSCTL_OFF + 64) + 2 * i;
    const unsigned lo = __builtin_amdgcn_readfirstlane(t[0]), hi = __builtin_amdgcn_readfirstlane(t[1]);
    return (const float*)(const GAS float*)(((unsigned long long)hi << 32) | lo);
}
#define PHASE_IDS int tid_ = (F.wv << 6) | hw_lane(); asm volatile("" : "+v"(tid_)); const int tid = tid_, lane = tid & 63, wave = __builtin_amdgcn_readfirstlane(tid >> 6); (void)lane; (void)wave
template <int CTRL> __device__ __forceinline__ float dppf(float v) { return __int_as_float(__builtin_amdgcn_mov_dpp(__float_as_int(v), CTRL, 0xF, 0xF, true)); }
#define DPP_XOR1 0xB1
#define DPP_XOR2 0x4E
#define DPP_HMIRROR 0x141
#define DPP_MIRROR 0x140
__device__ __forceinline__ float row16_sum(float v) {
    v += dppf<DPP_XOR1>(v); v += dppf<DPP_XOR2>(v); v += dppf<DPP_HMIRROR>(v); v += dppf<DPP_MIRROR>(v); return v;
}
template <int PAT> __device__ __forceinline__ float swz_xor(float v) { return __int_as_float(__builtin_amdgcn_ds_swizzle(__float_as_int(v), PAT)); }
__device__ __forceinline__ float wave_sum(float v) {
    v = row16_sum(v); v += swz_xor<0x401F>(v);
    const auto rr = __builtin_amdgcn_permlane32_swap(__float_as_uint(v), __float_as_uint(v), false, false);
    return __uint_as_float(rr[0]) + __uint_as_float(rr[1]);
}
__device__ __forceinline__ float silu_f(float x) { return x / (1.f + __expf(-x)); }

template <bool GLU_PERM, bool BIAS>
__device__ __forceinline__ float p0_transpose_item(const float* W, int K, int N, bf16* WT, LAS float* scr, int kb, int nb, int lane, const LAS float* shv = nullptr) {
    const int k0 = 64 * kb, n0 = 32 * nb;
    const int d0 = GLU_PERM ? ((n0 % DFF) / 128) * 256 + (n0 >= DFF ? 128 : 0) + (n0 % DFF) % 128 : n0;
#pragma unroll 8
    for (int i = 0; i < 32; ++i) { const int kk = 2 * i + (lane >> 5); scr[kk * 33 + (lane & 31)] = W[(size_t)(k0 + kk) * N + n0 + (lane & 31)]; }
    LDS_WAIT(); asm volatile("" ::: "memory");
    const int c = lane & 7;
#pragma unroll
    for (int j = 0; j < 4; ++j) { const int n = (lane >> 3) + 8 * j; const LAS float* s = scr + (8 * c) * 33 + n;
        v4u o; o.x = pk2(s[0 * 33], s[1 * 33]); o.y = pk2(s[2 * 33], s[3 * 33]); o.z = pk2(s[4 * 33], s[5 * 33]); o.w = pk2(s[6 * 33], s[7 * 33]);
        *(GAS v4u*)(WT + (size_t)(d0 + n) * K + k0 + 8 * c) = o; }
    float p = 0.f;
    if (BIAS) { const int sidx = lane >> 5, nn = lane & 31; const LAS float* sh = shv + sidx * DM + k0;
#pragma unroll 16
        for (int kk = 0; kk < 64; ++kk) p += sh[kk] * scr[kk * 33 + nn]; }
    LDS_WAIT(); asm volatile("" ::: "memory");
    return p;
}

__device__ __forceinline__ void p0a_phase(Frame& F) {
    PHASE_IDS;
    {
        LAS float* sact = (LAS float*)(F.lds);
        LAS float* red = (LAS float*)(F.lds + 16384);
        const float* cv = inptr(F, 1); const float* ccv = inptr(F, 3);
        for (int k = tid; k < DM; k += NWAVES * 64) { sact[k] = silu_f(cv[k]); sact[DM + k] = silu_f(ccv[k]); }
        __syncthreads();
        float* mod = (float*)(F.ws + WS_MOD);
        const int col4 = tid % 48, rg = tid / 48;
        for (int u = F.vcu; u < DEPTH * 64; u += F.G) {
            const int l = u >> 6, c0 = (u & 63) * 192;
            if (rg < 10) {
                f32x4 a0 = {0.f, 0.f, 0.f, 0.f}, a1 = {0.f, 0.f, 0.f, 0.f};
                const float* wp = inptr(F, 4) + (size_t)l * DM * NADA + c0 + 4 * col4;
#pragma unroll 8
                for (int k = rg; k < DM; k += 10) { const f32x4 w = *(const f32x4*)(wp + (size_t)k * NADA); const float s0 = sact[k], s1 = sact[DM + k]; a0 += w * s0; a1 += w * s1; }
                *(LAS f32x4*)(red + (rg * 2 + 0) * 192 + 4 * col4) = a0; *(LAS f32x4*)(red + (rg * 2 + 1) * 192 + 4 * col4) = a1;
            }
            __syncthreads();
            if (tid < 384) { const int sI = tid / 192, jj = tid % 192; float sum = 0.f;
#pragma unroll
                for (int r = 0; r < 10; ++r) sum += red[(r * 2 + sI) * 192 + jj];
                mod[(size_t)(l * 2 + sI) * NADA + c0 + jj] = sum + inptr(F, 5)[l * NADA + c0 + jj]; }
            __syncthreads();
        }
    }
    {
        float2* rt = (float2*)(F.ws + WS_ROPE);
        for (int i = F.vcu * (NWAVES * 64) + tid; i < 192 * 32; i += F.G * NWAVES * 64) {
            const int q = i >> 5, p = i & 31, pos = q < 128 ? q : q - 128;
            const float inv = exp2f(-(float)p * (13.287712379549449f / 32.f));
            const float ang = (float)pos * inv;
            rt[i] = make_float2(__cosf(ang), __sinf(ang));
        }
    }
    if (F.vcu == 0) { v4u* z0 = (v4u*)(F.ws + WS_HN); v4u* z1 = (v4u*)(F.ws + WS_HN + (size_t)(SEQ + 1) * DM * 2); const v4u zz = {0u, 0u, 0u, 0u};
        for (int i = tid; i < DM * 2 / 16; i += NWAVES * 64) { z0[i] = zz; z1[i] = zz; } }
}

__device__ __forceinline__ void p0b_phase(Frame& F) {
    PHASE_IDS;
    const float* mod = (const float*)(F.ws + WS_MOD);
    {
        const int gw = F.vcu * NWAVES + wave, NGW = F.G * NWAVES;
        bf16* HN = (bf16*)(F.ws + WS_HN); float* rowss = (float*)(F.ws + WS_CTL + CTL_ROWSS);
        for (int m = gw; m < MR; m += NGW) {
            const float* md = mod + (m >= SEQ ? NADA : 0) + DM;
            const f32x4* xr = (const f32x4*)(m < SEQ ? inptr(F, 0) + (size_t)m * DM : inptr(F, 2) + (size_t)(m - SEQ) * DM) + lane;
            f32x4 v[8]; float ssum = 0.f;
#pragma unroll
            for (int j = 0; j < 8; ++j) { v[j] = xr[64 * j]; ssum += (v[j].x * v[j].x + v[j].y * v[j].y) + (v[j].z * v[j].z + v[j].w * v[j].w); }
            ssum = wave_sum(ssum);
            if (lane == 0) rowss[m] = ssum;
            v2u* o8 = (v2u*)(HN + (size_t)(m < SEQ ? HN_LAT0 + m : HN_CTX0 + (m - SEQ)) * DM) + lane;
#pragma unroll
            for (int j = 0; j < 8; ++j) { const f32x4 sc = ((const f32x4*)md)[lane + 64 * j]; const f32x4 o = v[j] * (1.f + sc); v2u w; w.x = pk2(o.x, o.y); w.y = pk2(o.z, o.w); o8[64 * j] = w; }
        }
    }
    {
        LAS float* scr = (LAS float*)(F.lds + RING_OFF + wave * 12288);
        LAS float* shv = (LAS float*)(F.lds + RING_OFF + 8 * 12288);
        constexpr int U_QKV = (NQKV / 256) * (DM / 512), U_O = (DM / 256) * (DM / 512), U_IN = (NIN / 256) * (DM / 512), U_UP = (NUP / 256) * (DM / 512), U_DN = (DM / 256) * (DFF / 512);
        constexpr int NUNITS = 2 * (U_QKV + U_O + U_IN + U_O) + 4 * (U_UP + U_DN);
        float* bg1 = (float*)(F.ws + WS_BG1); float* bup = (float*)(F.ws + WS_BUP);
        int cur_mat = -1;
        for (int un = F.vcu; un < NUNITS; un += F.G) {
            int r = un, mt, j;
            if (r < 2 * U_QKV) { mt = 0; j = r / U_QKV; r %= U_QKV; }
            else if ((r -= 2 * U_QKV) < 2 * U_O) { mt = 1; j = r / U_O; r %= U_O; }
            else if ((r -= 2 * U_O) < 2 * U_IN) { mt = 2; j = r / U_IN; r %= U_IN; }
            else if ((r -= 2 * U_IN) < 2 * U_O) { mt = 3; j = r / U_O; r %= U_O; }
            else if ((r -= 2 * U_O) < 4 * U_UP) { mt = 4; j = r / U_UP; r %= U_UP; }
            else { r -= 4 * U_UP; mt = 5; j = r / U_DN; r %= U_DN; }
            const int N = mt == 0 ? NQKV : mt == 2 ? NIN : mt == 4 ? NUP : DM, K = mt == 5 ? DFF : DM;
            const int nstrip = N / 256, kq = r / nstrip, strip = r % nstrip, nb = strip * 8 + wave;
            const int want = mt == 0 ? (2 * j) * 2 : mt == 2 ? (2 * j + 1) * 2 : mt == 4 ? j * 2 + 1 : -1;
            if (want >= 0 && want != cur_mat) {
                __syncthreads();
                const int l = want >> 1, chunk = (want & 1) ? 3 : 0;
                for (int k = tid; k < 2 * DM; k += NWAVES * 64) shv[k] = mod[(size_t)(l * 2 + (k >= DM ? 1 : 0)) * NADA + chunk * DM + (k & (DM - 1))];
                cur_mat = want;
                __syncthreads();
            }
            float bacc = 0.f;
            for (int kbi = 0; kbi < 8; ++kbi) {
                const int kb = kq * 8 + kbi;
                if (mt == 0) bacc += p0_transpose_item<false, true>(inptr(F, 6) + (size_t)j * DM * NQKV, DM, NQKV, (bf16*)(F.ws + WS_WQKV + j * SZ_WQKV), scr, kb, nb, lane, shv);
                else if (mt == 1) p0_transpose_item<false, false>(inptr(F, 7) + (size_t)j * DM * DM, DM, DM, (bf16*)(F.ws + WS_WO + j * SZ_WO), scr, kb, nb, lane);
                else if (mt == 2) bacc += p0_transpose_item<false, true>(inptr(F, 11) + (size_t)j * DM * NIN, DM, NIN, (bf16*)(F.ws + WS_WIN + j * SZ_WIN), scr, kb, nb, lane, shv);
                else if (mt == 3) p0_transpose_item<false, false>(inptr(F, 13) + (size_t)j * DM * DM, DM, DM, (bf16*)(F.ws + WS_WOUT + j * SZ_WO), scr, kb, nb, lane);
                else if (mt == 4) bacc += p0_transpose_item<true, true>(inptr(F, 14) + (size_t)j * DM * NUP, DM, NUP, (bf16*)(F.ws + WS_WUP + j * SZ_WUP), scr, kb, nb, lane, shv);
                else p0_transpose_item<false, false>(inptr(F, 17) + (size_t)j * DFF * DM, DFF, DM, (bf16*)(F.ws + WS_WDN + j * SZ_WDN), scr, kb, nb, lane);
            }
            if (want >= 0) {
                float* bp = mt == 4 ? bup + (size_t)j * (SZ_BUP / 4) : bg1 + (size_t)(mt == 0 ? 2 * j : 2 * j + 1) * (SZ_BG1 / 4);
                bp[(size_t)(kq * 2 + (lane >> 5)) * N + nb * 32 + (lane & 31)] = bacc;
            }
        }
    }
}

__device__ __forceinline__ void qkr_phase(Frame& F, int M, const float* qg, const float* kg) {
    PHASE_IDS;
    const int gw = F.vcu * NWAVES + wave, NGW = F.G * NWAVES;
    bf16* QKV = (bf16*)(F.ws + WS_QKV);
    const float2* rowtab = (const float2*)(F.ws + WS_ROPE); const float2* coltab = rowtab + 128 * 32;
    const int i = lane & 15, grp = lane >> 4;
    for (int m = gw; m < M; m += NGW) {
        const bool lat = m < SEQ;
        const int a = i >> 3, pos = a == 0 ? (m >> 6) : (m & 63);
        const float2* tab = (a == 0 ? rowtab : coltab) + pos * 32 + (i & 3) * 8;
        const bool second = (i & 4) != 0;
        v4u raws[5];
#pragma unroll
        for (int it = 0; it < 5; ++it) raws[it] = *(const v4u*)(QKV + (size_t)m * NQKV + (it * 4 + grp) * HDIM + 8 * i);
        asm volatile("" ::: "memory");
#pragma unroll
        for (int it = 0; it < 5; ++it) {
            const int head = it * 4 + grp;
            v4u* p = (v4u*)(QKV + (size_t)m * NQKV + head * HDIM + 8 * i);
            const v4u raw = raws[it];
            float x[8] = {bf_lo(raw.x), bf_hi(raw.x), bf_lo(raw.y), bf_hi(raw.y), bf_lo(raw.z), bf_hi(raw.z), bf_lo(raw.w), bf_hi(raw.w)};
            float ss = 0.f;
#pragma unroll
            for (int e = 0; e < 8; ++e) ss += x[e] * x[e];
            ss = row16_sum(ss);
            const float r = rsqrtf(ss * (1.f / HDIM) + RMS_EPS);
            const float* g = (head < NHQ ? qg : kg) + 8 * i;
#pragma unroll
            for (int e = 0; e < 8; ++e) x[e] = x[e] * r * g[e];
            if (lat) {
#pragma unroll
                for (int e = 0; e < 8; ++e) { const float part = swz_xor<0x101F>(x[e]);     const float2 cs = tab[e]; x[e] = second ? x[e] * cs.x + part * cs.y : x[e] * cs.x - part * cs.y; }
            }
            v4u w; w.x = pk2(x[0], x[1]); w.y = pk2(x[2], x[3]); w.z = pk2(x[4], x[5]); w.w = pk2(x[6], x[7]);
            *p = w;
        }
    }
}

__device__ __forceinline__ void unpack8(const v4u raw, float (&x)[8]) { x[0] = bf_lo(raw.x); x[1] = bf_hi(raw.x); x[2] = bf_lo(raw.y); x[3] = bf_hi(raw.y); x[4] = bf_lo(raw.z); x[5] = bf_hi(raw.z); x[6] = bf_lo(raw.w); x[7] = bf_hi(raw.w); }

__device__ __forceinline__ void glu_phase(Frame& F, int M, const float* cw, const float* cb) {
    PHASE_IDS;
    const int gw = F.vcu * NWAVES + wave, NGW = F.G * NWAVES;
    const bf16* GV = (const bf16*)(F.ws + WS_GV); bf16* U = (bf16*)(F.ws + WS_U);
    const int NU = (M / 16) * (DFF / 512);
    for (int u = gw; u < NU; u += NGW) {
        const int strip = u / (DFF / 512), ch = u % (DFF / 512), r0 = strip * 16, c0 = ch * 512 + lane * 8;
        float w0[8], w1[8], w2[8], bb[8];
#pragma unroll
        for (int e = 0; e < 8; ++e) { w0[e] = cw[c0 + e]; w1[e] = cw[DFF + c0 + e]; w2[e] = cw[2 * DFF + c0 + e]; bb[e] = cb[c0 + e]; }
        const bool hasp = (r0 != 0 && r0 != SEQ), hasn = (r0 + 16 != SEQ && r0 + 16 != M);
        float gp[8], gc[8], gn[8], vv[8];
        const bf16* gbase = GV + (size_t)r0 * NUP + c0;
        if (hasp) unpack8(*(const v4u*)(gbase - NUP), gp); else {
#pragma unroll
            for (int e = 0; e < 8; ++e) gp[e] = 0.f; }
        unpack8(*(const v4u*)gbase, gc);
#pragma unroll 4
        for (int r = 0; r < 16; ++r) {
            const bf16* grow = gbase + (size_t)r * NUP;
            if (r < 15 || hasn) unpack8(*(const v4u*)(grow + NUP), gn); else {
#pragma unroll
                for (int e = 0; e < 8; ++e) gn[e] = 0.f; }
            unpack8(*(const v4u*)(grow + DFF), vv);
            float o[8];
#pragma unroll
            for (int e = 0; e < 8; ++e) { const float t = w0[e] * gp[e] + w1[e] * gc[e] + w2[e] * gn[e] + bb[e]; o[e] = silu_f(t) * vv[e]; gp[e] = gc[e]; gc[e] = gn[e]; }
            v4u w; w.x = pk2(o[0], o[1]); w.y = pk2(o[2], o[3]); w.z = pk2(o[4], o[5]); w.w = pk2(o[6], o[7]);
            *(v4u*)(U + (size_t)(r0 + r) * DFF + c0) = w;
        }
    }
}

__device__ __forceinline__ void sc_phase(Frame& F, int M, const float* cw) {
    PHASE_IDS;
    const int gw = F.vcu * NWAVES + wave, NGW = F.G * NWAVES;
    const bf16* BCV = (const bf16*)(F.ws + WS_BCV); bf16* Z = (bf16*)(F.ws + WS_Z);
    const int NU = (M / 16) * (DM / 512);
    for (int u = gw; u < NU; u += NGW) {
        const int strip = u / (DM / 512), ch = u % (DM / 512), r0 = strip * 16, c0 = ch * 512 + lane * 8;
        float w0[8], w1[8], w2[8];
#pragma unroll
        for (int e = 0; e < 8; ++e) { w0[e] = cw[c0 + e]; w1[e] = cw[DM + c0 + e]; w2[e] = cw[2 * DM + c0 + e]; }
        const bool hasp = (r0 != 0 && r0 != SEQ), hasn = (r0 + 16 != SEQ && r0 + 16 != M);
        float zp[8], zc[8], zn[8], t0[8], t1[8];
        const bf16* base = BCV + (size_t)r0 * NIN + c0;
        if (hasp) { unpack8(*(const v4u*)(base - NIN + DM), t0); unpack8(*(const v4u*)(base - NIN + 2 * DM), t1);
#pragma unroll
            for (int e = 0; e < 8; ++e) zp[e] = t0[e] * t1[e]; } else {
#pragma unroll
            for (int e = 0; e < 8; ++e) zp[e] = 0.f; }
        unpack8(*(const v4u*)(base + DM), t0); unpack8(*(const v4u*)(base + 2 * DM), t1);
#pragma unroll
        for (int e = 0; e < 8; ++e) zc[e] = t0[e] * t1[e];
        for (int rb = 0; rb < 16; rb += 4) {
            v4u rc[4], rv[4], rbv[4];
#pragma unroll
            for (int q = 0; q < 4; ++q) { const bf16* row = base + (size_t)(rb + q) * NIN; rc[q] = *(const v4u*)(row + NIN + DM); rv[q] = *(const v4u*)(row + NIN + 2 * DM); rbv[q] = *(const v4u*)row; }
            asm volatile("" ::: "memory");
#pragma unroll
            for (int q = 0; q < 4; ++q) { const int r = rb + q;
                unpack8(rc[q], t0); unpack8(rv[q], t1);
                const bool has = (r < 15) || hasn;
#pragma unroll
                for (int e = 0; e < 8; ++e) zn[e] = has ? t0[e] * t1[e] : 0.f;
                unpack8(rbv[q], t0);
                float o[8];
#pragma unroll
                for (int e = 0; e < 8; ++e) { o[e] = t0[e] * (w0[e] * zp[e] + w1[e] * zc[e] + w2[e] * zn[e]); zp[e] = zc[e]; zc[e] = zn[e]; }
                v4u w; w.x = pk2(o[0], o[1]); w.y = pk2(o[2], o[3]); w.z = pk2(o[4], o[5]); w.w = pk2(o[6], o[7]);
                *(v4u*)(Z + (size_t)(r0 + r) * DM + c0) = w;
            }
        }
    }
}

typedef short cg_bf16x8 __attribute__((ext_vector_type(8)));
typedef float cg_f32x16 __attribute__((ext_vector_type(16)));
template <int MODE, int KW>
__device__ __forceinline__ void ctx_gemm(Frame& F, const bf16* A, const bf16* Bt, int N, const float* Xi, float* Xo, const float* gate, bf16* HNo, const float* scn, float* rowss, bf16* Oc, int ldo, const float* bias) {
    PHASE_IDS;
    const int r32 = lane & 31, hi = lane >> 5;
    constexpr int K = KW * NWAVES, kw = KW;
    const int ncb = N / 32, nitems = (CTXL / 32) * ncb;
    LAS float* part = (LAS float*)(F.lds + RING_OFF);
    for (int it = F.vcu; it < nitems; it += F.G) {
        const int cb = it / (CTXL / 32), rb = it % (CTXL / 32);
        const bf16* ap = A + (size_t)(rb * 32 + r32) * K + wave * kw + hi * 8;
        const bf16* bp = Bt + (size_t)(cb * 32 + r32) * K + wave * kw + hi * 8;
        cg_f32x16 acc = {0.f, 0.f, 0.f, 0.f, 0.f, 0.f, 0.f, 0.f, 0.f, 0.f, 0.f, 0.f, 0.f, 0.f, 0.f, 0.f};
        constexpr int CH = (KW == 256) ? 16 : 22;
        static_assert(KW % (16 * CH) == 0, "ctx_gemm: chunking");
#pragma unroll 1
        for (int k = 0; k < KW; k += 16 * CH) {
            cg_bf16x8 a[CH], b[CH];
#pragma unroll
            for (int q = 0; q < CH; ++q) { a[q] = *(const cg_bf16x8*)(ap + k + 16 * q); b[q] = *(const cg_bf16x8*)(bp + k + 16 * q); }
            __builtin_amdgcn_sched_barrier(0);
#pragma unroll
            for (int q = 0; q < CH; ++q) acc = __builtin_amdgcn_mfma_f32_32x32x16_bf16(a[q], b[q], acc, 0, 0, 0);
            __builtin_amdgcn_sched_barrier(0);
        }
#pragma unroll
        for (int r = 0; r < 16; ++r) part[(wave * 16 + r) * 64 + lane] = acc[r];
        __syncthreads();
        float oldv[2] = {0.f, 0.f};
#pragma unroll
        for (int h = 0; h < 2; ++h) {
            const int e = tid + h * (NWAVES * 64), r = e >> 6, ln = e & 63;
            float sum = 0.f;
#pragma unroll
            for (int w = 0; w < NWAVES; ++w) sum += part[(w * 16 + r) * 64 + ln];
            const int row = rb * 32 + (r & 3) + 8 * (r >> 2) + 4 * (ln >> 5), col = cb * 32 + (ln & 31);
            if (MODE == 0) {
                const float y = Xi[(size_t)row * DM + col] + gate[col] * sum; Xo[(size_t)row * DM + col] = y;
                if (HNo) { HNo[(size_t)row * DM + col] = (bf16)(pk2(y * (1.f + scn[col]), 0.f) & 0xffffu);
                    float ss = row16_sum(y * y); ss += swz_xor<0x401F>(ss);
                    if ((ln & 31) == 0) oldv[h] = unsafeAtomicAdd(rowss + row, ss); }
            } else { const float rinv = __builtin_amdgcn_rsqf(pg8::ld_acc(rowss + row) * (1.f / DM) + RMS_EPS); const float bsum = (bias[(size_t)1 * N + col] + bias[(size_t)3 * N + col]) + (bias[(size_t)5 * N + col] + bias[(size_t)7 * N + col]);
                Oc[(size_t)row * ldo + col] = (bf16)(pk2(rinv * sum + bsum, 0.f) & 0xffffu); }
        }
        if (MODE == 0) asm volatile("" :: "v"(oldv[0]), "v"(oldv[1]));
        __syncthreads();
    }
}

__device__ __forceinline__ att::BlockRef<att::bf16, att::bf16> att_ref(int L, const att::bf16* QKV, att::bf16* AO, const float* sink) {
    att::BlockRef<att::bf16, att::bf16> r; int hq, row0;
    if (L < 512) { const int qb = L >> 4; hq = L & 15; row0 = qb * 256; r.jlo = qb == 0 ? 0 : 4 * qb - 2; const int jhi = (4 * qb + 6 > SEQ / 64) ? SEQ / 64 : 4 * qb + 6; r.ntb = jhi - r.jlo; }
    else { hq = L - 512; row0 = SEQ; r.jlo = 0; r.ntb = 0; }
    r.P0 = row0;
    r.Q = QKV + (size_t)row0 * NQKV + hq * HDIM; r.K = QKV + DM + (hq >> 2) * HDIM; r.V = QKV + DM + NHKV * HDIM + (hq >> 2) * HDIM; r.O = AO + (size_t)row0 * DM + hq * HDIM;
    r.m0 = sink[hq] * 11.313708498984761f;
    return r;
}
__device__ __forceinline__ void attn_phase(Frame& F, const float* sink, bool with_ctx) {
    const att::bf16* QKV = (const att::bf16*)(F.ws + WS_QKV); att::bf16* AO = (att::bf16*)(F.ws + WS_AO);
    const int NU = 512 + (with_ctx ? 16 : 0);
    int L = F.vcu; if (L >= NU) return;
    att::BlockRef<att::bf16, att::bf16> cur = att_ref(L, QKV, AO, sink);
    att::Seam<att::bf16> S;
    att::causal_swa_prime<att::bf16, att::bf16>(cur, F.ldsg + RING_OFF, S, F.wv);
    for (;;) {
        const bool more = L + F.G < NU; const int Ln = more ? L + F.G : L;
        const att::BlockRef<att::bf16, att::bf16> nxt = more ? att_ref(Ln, QKV, AO, sink) : cur;
        att::causal_swa_block<att::bf16, att::bf16>(cur, nxt, F.ldsg + RING_OFF, S, F.wv);
        if (!more) break;
        cur = nxt; L = Ln;
    }
}

#ifndef DUP_P0
#define DUP_P0 1
#endif
#ifndef DUP_N1
#define DUP_N1 1
#endif
#ifndef DUP_G1
#define DUP_G1 1
#endif
#ifndef DUP_SC
#define DUP_SC 1
#endif
#ifndef DUP_ATT
#define DUP_ATT 1
#endif
#ifndef DUP_N2
#define DUP_N2 1
#endif
#ifndef DUP_UP
#define DUP_UP 1
#endif
#ifndef DUP_GLU
#define DUP_GLU 1
#endif
struct Args { const float* in[18]; float* out; unsigned char* ws; int ph_lo, ph_hi; };
constexpr int N_PHASE_SLOTS = 2 + DEPTH * 6;
__global__ void __launch_bounds__(NWAVES * 64, 2) fwd_kernel(Args args) {
    extern __shared__ __attribute__((aligned(16))) unsigned char lds[];
    Frame F;
    F.lds = (LAS unsigned char*)lds; F.ldsg = (char*)lds;
    F.MISC = (volatile LAS unsigned*)(F.lds + MISC_OFF);
    F.G = gridDim.x; { const int bx = blockIdx.x; F.vcu = (F.G % 8 == 0) ? (bx % 8) * (F.G / 8) + bx / 8 : bx; }
    F.ws = args.ws; F.out = args.out;
    F.wv = __builtin_amdgcn_readfirstlane((int)threadIdx.x >> 6);
    for (int u = threadIdx.x; u < (LDS_BYTES - LDSCTL_OFF) / 4; u += NWAVES * 64) ((LAS unsigned*)(F.lds + LDSCTL_OFF))[u] = 0u;
    __syncthreads();
    if (threadIdx.x == 0) {
#pragma unroll
        for (int i = 0; i < 18; ++i) { const unsigned long long p = (unsigned long long)args.in[i]; LAS unsigned* t = (LAS unsigned*)(F.lds + LDSCTL_OFF + 64) + 2 * i; t[0] = (unsigned)p; t[1] = (unsigned)(p >> 32); }
    }
    __syncthreads();
    const int lo = args.ph_lo, hi = args.ph_hi;
    const bool single = (hi - lo) > 1;
    unsigned* barw = (unsigned*)(F.ws + WS_CTL) + CW_BAR;
    XcdBarrier bar; bar.bar = barw; bar.x = 0; bar.st = nullptr;
    if (single) bar = xcd_barrier_post(barw, F.MISC + 8, threadIdx.x == 0);
#define RUN(k) (lo <= (k) && (k) < hi)
#define GRID_BAR() do { if (single) xcd_barrier(bar, F.wv); } while (0)
    float* mod = (float*)(F.ws + WS_MOD);
    bf16* HN = (bf16*)(F.ws + WS_HN); float* XR = (float*)(F.ws + WS_XR);

    if (RUN(0)) { p0a_phase(F); GRID_BAR(); }
    if (RUN(1)) { for (int rep = 0; rep < DUP_P0; ++rep) { p0b_phase(F); __syncthreads(); } GRID_BAR(); }

    float* rowss_all = (float*)(F.ws + WS_CTL + CTL_ROWSS);
    for (int l = 0; l < DEPTH; ++l) {
        const int pb = 2 + l * 6, j = l >> 1; const bool attn = (l & 1) == 0;
        const bool ctx_g1 = l < 3;
        const bool ctx_on = l < 2;
        const float* mod_l = mod + (size_t)l * 2 * NADA;
        float* rowss_m = rowss_all + (size_t)(2 * l) * MR;
        float* rowss_f = rowss_all + (size_t)(2 * l + 1) * MR;
        if (RUN(pb + 0)) {
            const int N = attn ? NQKV : NIN;
            const bf16* Bt = attn ? (const bf16*)(F.ws + WS_WQKV + j * SZ_WQKV) : (const bf16*)(F.ws + WS_WIN + j * SZ_WIN);
            const float* bias = (const float*)(F.ws + WS_BG1 + (size_t)l * SZ_BG1);
            const int Mg = (attn && ctx_g1) ? MR : SEQ;
            if (!attn && ctx_g1 && ctx_on) ctx_gemm<1, DM / NWAVES>(F, HN + (size_t)HN_CTX0 * DM, Bt, N, nullptr, nullptr, nullptr, nullptr, nullptr, rowss_m + SEQ, (bf16*)(F.ws + WS_R1) + (size_t)SEQ * N, N, bias);
            pg8::Gemm g{HN, Bt, Mg, N, DM, HN_LAT0, 256, SEQ / 256, HN_CTX0}; pg8::StaticOrder S; S.init(Mg, N, F.G, (int)blockIdx.x);
            pg8::EpiBf16 E{(bf16*)(F.ws + WS_R1), N, rowss_m, bias, N, SEQ / 256, 1.f / DM, RMS_EPS};
            for (int rep = 0; rep < DUP_G1; ++rep) pg8::gemm_phase<pg8::EpiBf16, pg8::StaticOrder, true, true>(F.lds + RING_OFF, g, S, E, F.wv);
            GRID_BAR();
        }
        if (attn) {
            if (RUN(pb + 1)) { qkr_phase(F, ctx_g1 ? MR : SEQ, inptr(F, 8) + j * HDIM, inptr(F, 9) + j * HDIM); GRID_BAR(); }
            if (RUN(pb + 2)) { for (int rep = 0; rep < DUP_ATT; ++rep) attn_phase(F, inptr(F, 10) + j * NHQ, ctx_on); GRID_BAR(); }
        } else {
            if (RUN(pb + 1)) { for (int rep = 0; rep < DUP_SC; ++rep) sc_phase(F, ctx_on ? MR : SEQ, inptr(F, 12) + (size_t)j * 3 * DM); GRID_BAR(); }
        }
        if (RUN(pb + 3)) {
            const bf16* A = attn ? (const bf16*)(F.ws + WS_AO) : (const bf16*)(F.ws + WS_Z);
            const bf16* Bt = attn ? (const bf16*)(F.ws + WS_WO + j * SZ_WO) : (const bf16*)(F.ws + WS_WOUT + j * SZ_WO);
            const float* Xl = (l == 0) ? inptr(F, 0) : XR;
            const float* Xc = (l == 0) ? inptr(F, 2) : XR + (size_t)SEQ * DM;
            if (ctx_on) ctx_gemm<0, DM / NWAVES>(F, A + (size_t)SEQ * DM, Bt, DM, Xc, XR + (size_t)SEQ * DM, mod_l + NADA + 2 * DM, HN + (size_t)HN_CTX0 * DM, mod_l + NADA + 4 * DM, rowss_f + SEQ, nullptr, 0, nullptr);
            pg8::Gemm g{A, Bt, SEQ, DM, DM, 0, 256, 1 << 30, 0}; pg8::StaticOrder S; S.init(SEQ, DM, F.G, (int)blockIdx.x);
            pg8::EpiResid E{Xl, XR, DM, mod_l + 2 * DM, HN, mod_l + 4 * DM, rowss_f, HN_LAT0};
            pg8::gemm_phase<pg8::EpiResid, pg8::StaticOrder, true, true>(F.lds + RING_OFF, g, S, E, F.wv);
            GRID_BAR();
        }
        if (RUN(pb + 4)) {
            const int nM = (SEQ + 253) / 254 + (ctx_on ? 1 : 0);
            const float* bias = (const float*)(F.ws + WS_BUP + (size_t)l * SZ_BUP);
            pg8::Gemm g{HN, (const bf16*)(F.ws + WS_WUP + l * SZ_WUP), nM * 256, NUP, DM, 0, 254, (SEQ + 253) / 254, HN_CTX0}; pg8::StaticOrder S; S.init(nM * 256, NUP, F.G, (int)blockIdx.x);
            pg8::EpiGlu E{(bf16*)(F.ws + WS_U), DFF, inptr(F, 15) + (size_t)l * 3 * DFF, inptr(F, 16) + (size_t)l * DFF, DFF, (PG8_LAS pg8::f32x4*)(F.lds + XCH_OFF), (SEQ + 253) / 254, SEQ,
                          rowss_f, bias, NUP, 1.f / DM, RMS_EPS};
            for (int rep = 0; rep < DUP_UP; ++rep) pg8::gemm_phase<pg8::EpiGlu, pg8::StaticOrder, true, true>(F.lds + RING_OFF, g, S, E, F.wv);
            GRID_BAR();
        }
        if (RUN(pb + 5)) {
            const bool last = l == DEPTH - 1;
            const float* mod_n = mod_l + 2 * NADA;
            float* rowss_n = rowss_all + (size_t)(2 * l + 2 < 8 ? 2 * l + 2 : 0) * MR;
            if (ctx_on) ctx_gemm<0, DFF / NWAVES>(F, (const bf16*)(F.ws + WS_U) + (size_t)SEQ * DFF, (const bf16*)(F.ws + WS_WDN + l * SZ_WDN), DM, XR + (size_t)SEQ * DM, XR + (size_t)SEQ * DM, mod_l + NADA + 5 * DM,
                                                  HN + (size_t)HN_CTX0 * DM, mod_n + NADA + DM, rowss_n + SEQ, nullptr, 0, nullptr);
            pg8::Gemm g{(const bf16*)(F.ws + WS_U), (const bf16*)(F.ws + WS_WDN + l * SZ_WDN), SEQ, DM, DFF, 0, 256, 1 << 30, 0}; pg8::StaticOrder S; S.init(SEQ, DM, F.G, (int)blockIdx.x);
            pg8::EpiResid E{XR, last ? F.out : XR, DM, mod_l + 5 * DM, last ? (bf16*)nullptr : HN, last ? mod_l + DM : mod_n + DM, rowss_n, HN_LAT0};
            pg8::gemm_phase<pg8::EpiResid, pg8::StaticOrder, true, true>(F.lds + RING_OFF, g, S, E, F.wv);
            if (!last) GRID_BAR();
        }
    }
#undef RUN
#undef GRID_BAR
}

#ifndef MK_PER_PHASE
#define MK_PER_PHASE 0
#endif
extern "C" void kernel_launch(void* const* d_in, const int* in_sizes, int n_in, void* d_out, int out_size, void* d_ws, size_t ws_size, hipStream_t stream) {
    static int grid = 0;
    if (grid == 0) {
        if (n_in != 18 || in_sizes[0] != SEQ * DM || out_size != SEQ * DM || ws_size < WS_END) { fprintf(stderr, "kernel_launch: unexpected shapes (n_in %d, in0 %d, out %d, ws %zu < %zu?); nothing launched\n", n_in, n_in > 0 ? in_sizes[0] : -1, out_size, ws_size, (size_t)WS_END); grid = -1; return; }
        int dev = 0, cus = 0, per_cu = 0;
        if (hipGetDevice(&dev) != hipSuccess || hipDeviceGetAttribute(&cus, hipDeviceAttributeMultiprocessorCount, dev) != hipSuccess) { fprintf(stderr, "kernel_launch: device query failed\n"); grid = -1; return; }
        if (hipFuncSetAttribute((const void*)fwd_kernel, hipFuncAttributeMaxDynamicSharedMemorySize, LDS_BYTES) != hipSuccess) { fprintf(stderr, "kernel_launch: hipFuncSetAttribute failed\n"); grid = -1; return; }
        if (hipOccupancyMaxActiveBlocksPerMultiprocessor(&per_cu, (const void*)fwd_kernel, NWAVES * 64, LDS_BYTES) != hipSuccess || per_cu < 1)
            fprintf(stderr, "kernel_launch: note: occupancy query reports %d workgroups per CU\n", per_cu);
        (void)hipGetLastError();
        grid = cus;
    }
    if (grid < 0) return;
    if (hipMemsetAsync((char*)d_ws + WS_CTL, 0, CTL_ZERO_BYTES, stream) != hipSuccess) { fprintf(stderr, "kernel_launch: hipMemsetAsync failed\n"); return; }
    Args a{};
    for (int i = 0; i < 18; ++i) a.in[i] = (const float*)d_in[i];
    a.out = (float*)d_out; a.ws = (unsigned char*)d_ws;
#if MK_PER_PHASE
    for (int ph = 0; ph < N_PHASE_SLOTS; ++ph) {
        const int slot = ph < 2 ? -1 : (ph - 2) % 6, l = ph < 2 ? 0 : (ph - 2) / 6;
        if (slot == 2 && (l & 1)) continue;
        a.ph_lo = ph; a.ph_hi = ph + 1;
        hipLaunchKernelGGL(fwd_kernel, dim3(grid), dim3(NWAVES * 64), LDS_BYTES, stream, a);
    }
#else
    a.ph_lo = 0; a.ph_hi = N_PHASE_SLOTS;
    hipLaunchKernelGGL(fwd_kernel, dim3(grid), dim3(NWAVES * 64), LDS_BYTES, stream, a);
#endif
    const hipError_t le = hipPeekAtLastError();
    if (le != hipSuccess) fprintf(stderr, "kernel_launch: launch failed: %s\n", hipGetErrorName(le));
}
```

```cpp
#include <hip/hip_runtime.h>
#include <hip/hip_bf16.h>
#include <cstdio>
#include <cstdint>

__device__ __forceinline__ int hw_lane() { int l; asm volatile("v_mbcnt_lo_u32_b32 %0, -1, 0\n\tv_mbcnt_hi_u32_b32 %0, -1, %0" : "=v"(l)); return l; }

namespace pg8 {
#define PG8_LAS __attribute__((address_space(3)))
typedef unsigned short bf16_t;
typedef short bf16x8 __attribute__((ext_vector_type(8)));
typedef float f32x4 __attribute__((ext_vector_type(4)));
typedef unsigned u32x4 __attribute__((ext_vector_type(4)));
constexpr int BM = 256, BK = 64, HALF = 128, HTB = HALF * BK * 2  , STAGE_BYTES = 8 * HTB, NXCD = 8, WGM = 8;

__host__ __device__ __forceinline__ int lds_byte(int r, int c) { const int st = (r >> 4) * 2 + (c >> 5), rr = r & 15, cc = c & 31, ob = rr * 64 + cc * 2; return st * 1024 + (ob ^ (((ob >> 9) & 1) << 5)); }
__host__ __device__ __forceinline__ void stage_rc(int b, int& R, int& C) { const int st = b / 1024, sb = b % 1024, swz = sb ^ (((sb >> 9) & 1) << 5); R = (st >> 1) * 16 + swz / 64; C = (st & 1) * 32 + (swz % 64) / 2; }
__host__ __device__ __forceinline__ int perm32(int rho) { const int n = rho >> 4, i = rho & 15; return 8 * (i >> 2) + 4 * n + (i & 3); }

struct Unit { int pm, pn; };
struct Gemm { const bf16_t* A; const bf16_t* Bt; int M, N, K;
    int a_row0, a_rstride, ctx_pm, ctx_row;
    __host__ __device__ __forceinline__ size_t arow(int pm) const { return pm >= ctx_pm ? (size_t)ctx_row : (size_t)(a_row0 + pm * a_rstride); } };

struct StaticOrder {
    int nM, nN, nwg, G, c;
    __host__ __device__ void init(int M, int N, int G_, int c_) { nM = M / BM; nN = N / BM; nwg = nM * nN; G = G_; c = c_; }
    __host__ __device__ bool next(int i, Unit& u) const {
        const long L = (long)i * G + c; if (L >= nwg) return false;
        int wgid = (int)L; { const int q = nwg / NXCD, r = nwg % NXCD, xcd = wgid % NXCD, off = wgid / NXCD; wgid = (xcd < r ? xcd * (q + 1) : r * (q + 1) + (xcd - r) * q) + off; }
        const int nig = WGM * nN, gid = wgid / nig, fm = gid * WGM, gsz = (nM - fm) < WGM ? (nM - fm) : WGM;
        u.pm = fm + ((wgid % nig) % gsz); u.pn = (wgid % nig) / gsz; return true;
    }
    __device__ __forceinline__ void a_ready(const Unit&) const {}
    __device__ __forceinline__ void done(const Unit&) const {}
};

__device__ __forceinline__ unsigned cvt_pk_bf16(float lo, float hi) { unsigned r; asm volatile("v_cvt_pk_bf16_f32 %0, %1, %2" : "=v"(r) : "v"(lo), "v"(hi)); return r; }

template <int CTRL> __device__ __forceinline__ float dpp_mov(float v) { return __int_as_float(__builtin_amdgcn_mov_dpp(__float_as_int(v), CTRL, 0xF, 0xF, true)); }
__device__ __forceinline__ float fq_sum(float v) {
    v += __int_as_float(__builtin_amdgcn_ds_swizzle(__float_as_int(v), 0x401F));
    const auto rr = __builtin_amdgcn_permlane32_swap(__float_as_uint(v), __float_as_uint(v), false, false);
    return __uint_as_float(rr[0]) + __uint_as_float(rr[1]);
}
__device__ __forceinline__ float ld_acc(const float* p) { return __uint_as_float(__hip_atomic_load((const unsigned*)p, __ATOMIC_RELAXED, __HIP_MEMORY_SCOPE_AGENT)); }
__device__ __forceinline__ f32x4 ld_bias4(const float* b, int nb, int stream, int col) { const float* p = b + (size_t)stream * nb + col; const size_t q = (size_t)2 * nb;
    return (*(const f32x4*)p + *(const f32x4*)(p + q)) + (*(const f32x4*)(p + 2 * q) + *(const f32x4*)(p + 3 * q)); }
struct EpiBf16 {
    static constexpr bool PERM = true, AFTER_DRAIN = false;
    bf16_t* O; int ldc; const float* rowss; const float* bias; int nb; int pm_ctx; float inv_k, eps;
    __device__ __forceinline__ void operator()(f32x4 (&acc)[2][2][4][2], const Unit& u, int wr, int wc, int fr, int fq) const {
        const int row0 = u.pm * BM + wr * 64 + fr, col0 = u.pn * BM + wc * 32 + 8 * fq;
        const int stream = (u.pm >= pm_ctx) ? 1 : 0;
        float rs[8];
#pragma unroll
        for (int i = 0; i < 8; ++i) rs[i] = ld_acc(rowss + row0 + (i >> 2) * HALF + (i & 3) * 16);
        f32x4 bv[2][2];
#pragma unroll
        for (int bj = 0; bj < 2; ++bj)
#pragma unroll
            for (int n = 0; n < 2; ++n) bv[bj][n] = (f32x4){0.f, 0.f, 0.f, 0.f};
        { f32x4 bp[4][2][2];
#pragma unroll
          for (int q = 0; q < 4; ++q)
#pragma unroll
            for (int bj = 0; bj < 2; ++bj)
#pragma unroll
                for (int n = 0; n < 2; ++n) bp[q][bj][n] = *(const f32x4*)(bias + (size_t)(2 * q + stream) * nb + col0 + bj * HALF + 4 * n);
          asm volatile("" ::: "memory");
#pragma unroll
          for (int bj = 0; bj < 2; ++bj)
#pragma unroll
            for (int n = 0; n < 2; ++n) bv[bj][n] = (bp[0][bj][n] + bp[1][bj][n]) + (bp[2][bj][n] + bp[3][bj][n]); }
#pragma unroll
        for (int ai = 0; ai < 2; ++ai)
#pragma unroll
            for (int m = 0; m < 4; ++m) { const int row = row0 + ai * HALF + m * 16; const float r = __builtin_amdgcn_rsqf(rs[ai * 4 + m] * inv_k + eps);
                bf16_t* rowp = O + (size_t)row * ldc + col0;
#pragma unroll
                for (int bj = 0; bj < 2; ++bj) { const f32x4 v0 = acc[ai][bj][m][0] * r + bv[bj][0], v1 = acc[ai][bj][m][1] * r + bv[bj][1];
                    u32x4 w; w.x = cvt_pk_bf16(v0[0], v0[1]); w.y = cvt_pk_bf16(v0[2], v0[3]); w.z = cvt_pk_bf16(v1[0], v1[1]); w.w = cvt_pk_bf16(v1[2], v1[3]);
                    *(u32x4*)(rowp + bj * HALF) = w; } }
    }
};
struct EpiResid {
    static constexpr bool PERM = false, AFTER_DRAIN = false;
    const float* X; float* Y; int ldc; const float* gate; bf16_t* HNo; const float* scn; float* rowss; int hn_row0;
    __device__ __forceinline__ void operator()(f32x4 (&acc)[2][2][4][2], const Unit& u, int wr, int wc, int fr, int fq) const {
        const int row0 = u.pm * BM + wr * 64 + fr, col0 = u.pn * BM + wc * 32 + 4 * fq;
        f32x4 gv[2][2], sv[2][2]; float ssq[8];
#pragma unroll
        for (int bj = 0; bj < 2; ++bj)
#pragma unroll
            for (int n = 0; n < 2; ++n) { gv[bj][n] = *(const f32x4*)(gate + col0 + bj * HALF + n * 16); sv[bj][n] = *(const f32x4*)(scn + col0 + bj * HALF + n * 16) + 1.f; }
#pragma unroll
        for (int ai = 0; ai < 2; ++ai)
#pragma unroll
            for (int mp = 0; mp < 2; ++mp) {
                f32x4 xv[2][2][2];
#pragma unroll
                for (int mm = 0; mm < 2; ++mm)
#pragma unroll
                    for (int bj = 0; bj < 2; ++bj)
#pragma unroll
                        for (int n = 0; n < 2; ++n) xv[mm][bj][n] = *(const f32x4*)(X + (size_t)(row0 + ai * HALF + (2 * mp + mm) * 16) * ldc + col0 + bj * HALF + n * 16);
                asm volatile("" ::: "memory");
#pragma unroll
                for (int mm = 0; mm < 2; ++mm) { const int m = 2 * mp + mm; const int row = row0 + ai * HALF + m * 16; const size_t off = (size_t)row * ldc + col0; float ss = 0.f;
#pragma unroll
                    for (int bj = 0; bj < 2; ++bj)
#pragma unroll
                        for (int n = 0; n < 2; ++n) { const f32x4 y = xv[mm][bj][n] + gv[bj][n] * acc[ai][bj][m][n];
                            *(f32x4*)(Y + off + bj * HALF + n * 16) = y;
                            if (HNo) { ss += (y[0] * y[0] + y[1] * y[1]) + (y[2] * y[2] + y[3] * y[3]); const f32x4 a = y * sv[bj][n];
                                typedef unsigned u32x2v __attribute__((ext_vector_type(2))); u32x2v w; w.x = cvt_pk_bf16(a[0], a[1]); w.y = cvt_pk_bf16(a[2], a[3]);
                                *(u32x2v*)(HNo + (size_t)(hn_row0 + row) * ldc + col0 + bj * HALF + n * 16) = w; } }
                    ssq[ai * 4 + m] = HNo ? fq_sum(ss) : 0.f; }
                asm volatile("" ::: "memory");
            }
        if (HNo && fq == 0) {
#pragma unroll
            for (int i = 0; i < 8; ++i) unsafeAtomicAdd(rowss + row0 + (i >> 2) * HALF + (i & 3) * 16, ssq[i]);
        }
    }
};

struct EpiGlu {
    static constexpr bool PERM = true, AFTER_DRAIN = false;
    bf16_t* U; int ldu; const float* cw; const float* cb; int dff; PG8_LAS f32x4* xch; int ctx_pm, seq;
    const float* rowss; const float* bias; int nb; float inv_k, eps;
    static __device__ __forceinline__ int xi(int ci, int which, int wc, int n, int fq) { return (((ci * 2 + which) * 4 + wc) * 2 + n) * 4 + fq; }
    __device__ __forceinline__ void operator()(f32x4 (&acc)[2][2][4][2], const Unit& u, int wr, int wc, int fr_, int fq_) const {
        int t_ = hw_lane(); asm volatile("" : "+v"(t_)); const int fr = t_ & 15, fq = (t_ >> 4) & 3; (void)fr_; (void)fq_;
        const int ch0 = u.pn * 128 + wc * 32 + 8 * fq;
        const bool is_ctx = u.pm >= ctx_pm;
        { const int stream = is_ctx ? 1 : 0; f32x4 bg[2], bv[2];
#pragma unroll
            for (int n = 0; n < 2; ++n) { bg[n] = ld_bias4(bias, nb, stream, ch0 + 4 * n); bv[n] = ld_bias4(bias, nb, stream, dff + ch0 + 4 * n); }
            float rs[8];
#pragma unroll
            for (int i = 0; i < 8; ++i) { const int R = 128 * (i >> 2) + 64 * wr + 16 * (i & 3) + fr; const int trow = is_ctx ? seq + R : 254 * u.pm - 1 + R;
                rs[i] = ld_acc(rowss + (is_ctx ? trow : (trow < 0 ? 0 : (trow >= seq ? seq - 1 : trow)))); }
#pragma unroll
            for (int ai = 0; ai < 2; ++ai)
#pragma unroll
                for (int m = 0; m < 4; ++m) { const int R = 128 * ai + 64 * wr + 16 * m + fr; const int trow = is_ctx ? seq + R : 254 * u.pm - 1 + R;
                    const bool valid = is_ctx || (trow >= 0 && trow < seq);
                    const float r = valid ? __builtin_amdgcn_rsqf(rs[ai * 4 + m] * inv_k + eps) : 0.f;
#pragma unroll
                    for (int n = 0; n < 2; ++n) { const f32x4 g = acc[ai][0][m][n] * r + bg[n]; acc[ai][0][m][n] = valid ? g : (f32x4){0.f, 0.f, 0.f, 0.f}; acc[ai][1][m][n] = acc[ai][1][m][n] * r + bv[n]; } } }
#pragma unroll
        for (int ai = 0; ai < 2; ++ai) { const int ci = 2 * ai + wr;
            if (fr == 0) {
#pragma unroll
                for (int n = 0; n < 2; ++n) xch[xi(ci, 0, wc, n, fq)] = acc[ai][0][0][n]; }
            if (fr == 15) {
#pragma unroll
                for (int n = 0; n < 2; ++n) xch[xi(ci, 1, wc, n, fq)] = acc[ai][0][3][n]; } }
        asm volatile("s_waitcnt lgkmcnt(0)" ::: "memory"); __builtin_amdgcn_s_barrier(); asm volatile("" ::: "memory");
        f32x4 w0[2], w1[2], w2[2], bb[2];
#pragma unroll
        for (int n = 0; n < 2; ++n) { w0[n] = *(const f32x4*)(cw + ch0 + 4 * n); w1[n] = *(const f32x4*)(cw + dff + ch0 + 4 * n); w2[n] = *(const f32x4*)(cw + 2 * dff + ch0 + 4 * n); bb[n] = *(const f32x4*)(cb + ch0 + 4 * n); }
        const bool l15 = fr == 15, l0 = fr == 0;
#pragma unroll
        for (int ai = 0; ai < 2; ++ai) { const int ci = 2 * ai + wr;
            f32x4 up[2], dn[2];
#pragma unroll
            for (int n = 0; n < 2; ++n) { up[n] = (f32x4){0.f, 0.f, 0.f, 0.f}; dn[n] = (f32x4){0.f, 0.f, 0.f, 0.f};
                if (ci > 0) up[n] = xch[xi(ci - 1, 1, wc, n, fq)];
                if (ci < 3) dn[n] = xch[xi(ci + 1, 0, wc, n, fq)]; }
#pragma unroll
            for (int m = 0; m < 4; ++m) {
                const int R = 128 * ai + 64 * wr + 16 * m + fr;
                float o[8];
#pragma unroll
                for (int n = 0; n < 2; ++n)
#pragma unroll
                    for (int e = 0; e < 4; ++e) {
                        const float x = acc[ai][0][m][n][e];
                        const float xm1 = m > 0 ? acc[ai][0][m > 0 ? m - 1 : 0][n][e] : up[n][e];
                        const float xp1 = m < 3 ? acc[ai][0][m < 3 ? m + 1 : 3][n][e] : dn[n][e];
                        const float gu = dpp_mov<0x121>(l15 ? xm1 : x);
                        const float gd = dpp_mov<0x12F>(l0 ? xp1 : x);
                        const float t = w0[n][e] * gu + w1[n][e] * x + w2[n][e] * gd + bb[n][e];
                        o[4 * n + e] = t * __builtin_amdgcn_rcpf(1.f + __expf(-t)) * acc[ai][1][m][n][e];
                    }
                u32x4 w; w.x = cvt_pk_bf16(o[0], o[1]); w.y = cvt_pk_bf16(o[2], o[3]); w.z = cvt_pk_bf16(o[4], o[5]); w.w = cvt_pk_bf16(o[6], o[7]);
                int grow; bool ok;
                if (is_ctx) { grow = seq + R; ok = true; } else { grow = 254 * u.pm - 1 + R; ok = (R >= 1) && (R <= 254) && (grow < seq); }
                if (ok) *(u32x4*)(U + (size_t)grow * ldu + ch0) = w;
            }
        }
    }
};
template <class Epi, class Sched, bool ALIGN_EPI = false, bool SP2 = false>
__device__ __forceinline__ void gemm_phase(PG8_LAS unsigned char* lds, const Gemm g, const Sched& S, const Epi& E, const int wv  ) {
    int tid_ = (wv << 6) | hw_lane(); asm volatile("" : "+v"(tid_));
    const int tid = tid_, wid = __builtin_amdgcn_readfirstlane(tid >> 6), lane = tid & 63, wr = wid >> 2, wc = wid & 3, fr = lane & 15, fq = lane >> 4;
    const int K = g.K, nt = K / BK;
    unsigned voffA[2], voffB[2];
#pragma unroll
    for (int i = 0; i < 2; ++i) { int R, C; stage_rc(tid * 16 + i * 8192, R, C); const int Rb = Epi::PERM ? ((R & ~31) + perm32(R & 31)) : R;
        voffA[i] = (unsigned)(R * K + C) * 2u; voffB[i] = (unsigned)(Rb * K + C) * 2u; }
    const size_t kstep = (size_t)(BK * 2);
    const size_t hstep = (size_t)HALF * K * 2;
    const size_t tstep = 2 * hstep;
    const unsigned ldsw = (unsigned)wid * 1024u;
    const int aoff = lds_byte(wr * 64 + fr, fq * 8), boff = lds_byte(wc * 32 + fr, fq * 8);
#define PG8_SA(b, h) (((b) * 2 + (h)) * HTB)
#define PG8_SB(b, h) ((4 + (b) * 2 + (h)) * HTB)
#define PG8_STAGE(bufoff, gbase, voff) do { _Pragma("unroll") for (int _i = 0; _i < 2; ++_i) \
        __builtin_amdgcn_global_load_lds((const unsigned*)((const char*)(gbase) + (voff)[_i]), (PG8_LAS unsigned*)(lds + (bufoff) + ldsw + _i * 8192), 16, 0, 0); } while (0)
#define PG8_LDA(dst, b, h) do { _Pragma("unroll") for (int m = 0; m < 4; ++m) _Pragma("unroll") for (int k = 0; k < 2; ++k) dst[m][k] = *(const PG8_LAS bf16x8*)(lds + PG8_SA(b, h) + aoff + m * 2048 + k * 1024); } while (0)
#define PG8_LDB(dst, b, h) do { _Pragma("unroll") for (int n = 0; n < 2; ++n) _Pragma("unroll") for (int k = 0; k < 2; ++k) dst[n][k] = *(const PG8_LAS bf16x8*)(lds + PG8_SB(b, h) + boff + n * 2048 + k * 1024); } while (0)
#define PG8_MMA(ai, bj, At, Bt) do { __builtin_amdgcn_s_setprio(1); _Pragma("unroll") for (int m = 0; m < 4; ++m) _Pragma("unroll") for (int n = 0; n < 2; ++n) _Pragma("unroll") for (int k = 0; k < 2; ++k) \
        acc[ai][bj][m][n] = __builtin_amdgcn_mfma_f32_16x16x32_bf16(Bt[n][k], At[m][k], acc[ai][bj][m][n], 0, 0, 0); __builtin_amdgcn_s_setprio(0); } while (0)
#define PG8_WAIT_V(n) asm volatile("s_waitcnt vmcnt(" #n ")" ::: "memory")
#define PG8_WAIT_L(n) asm volatile("s_waitcnt lgkmcnt(" #n ")" ::: "memory")
#define PG8_BAR __builtin_amdgcn_s_barrier()
#define PG8_SCHED __builtin_amdgcn_sched_barrier(0)
    Unit cur, nxt; int ui = 0;
    if (!S.next(0, cur)) return;
    f32x4 acc[2][2][4][2];
#pragma unroll
    for (int a = 0; a < 2; ++a)
#pragma unroll
        for (int b = 0; b < 2; ++b)
#pragma unroll
            for (int m = 0; m < 4; ++m)
#pragma unroll
                for (int n = 0; n < 2; ++n) acc[a][b][m][n] = (f32x4){0.f, 0.f, 0.f, 0.f};
    bf16x8 At[4][2], B0[2][2], B1[2][2];
    const size_t rstepA = (size_t)K * 2;
    const char* cA = (const char*)g.A + g.arow(cur.pm) * rstepA; const char* cB = (const char*)g.Bt + (size_t)cur.pn * tstep;
    S.a_ready(cur);
    if constexpr (SP2) {
        PG8_STAGE(PG8_SB(0, 0), cB, voffB); PG8_STAGE(PG8_SB(0, 1), cB + hstep, voffB); PG8_STAGE(PG8_SA(0, 0), cA, voffA); PG8_STAGE(PG8_SA(0, 1), cA + hstep, voffA);
        if (wr == 1) PG8_BAR;
        PG8_WAIT_V(2); PG8_BAR;
        PG8_STAGE(PG8_SB(1, 0), cB + kstep, voffB); PG8_STAGE(PG8_SA(1, 0), cA + kstep, voffA); PG8_STAGE(PG8_SB(1, 1), cB + hstep + kstep, voffB);
        PG8_WAIT_V(6); PG8_BAR;
    } else {
        PG8_STAGE(PG8_SB(0, 0), cB, voffB); PG8_STAGE(PG8_SA(0, 0), cA, voffA); PG8_STAGE(PG8_SB(0, 1), cB + hstep, voffB); PG8_STAGE(PG8_SA(0, 1), cA + hstep, voffA);
        if (wr == 1) PG8_BAR;
        PG8_WAIT_V(4); PG8_BAR;
        PG8_STAGE(PG8_SB(1, 0), cB + kstep, voffB); PG8_STAGE(PG8_SA(1, 0), cA + kstep, voffA); PG8_STAGE(PG8_SB(1, 1), cB + hstep + kstep, voffB);
        PG8_WAIT_V(6); PG8_BAR;
    }
    for (;;) {
        const bool has_next = S.next(ui + 1, nxt);
        const char* nA = has_next ? (const char*)g.A + g.arow(nxt.pm) * rstepA : cA; const char* nB = has_next ? (const char*)g.Bt + (size_t)nxt.pn * tstep : cB;
        for (int t = 0; t < nt; t += 2) {
            const bool last = (t == nt - 2);
            const char* a1 = cA + (size_t)(t + 1) * kstep;
            const char* a2 = last ? nA : cA + (size_t)(t + 2) * kstep; const char* b2 = last ? nB : cB + (size_t)(t + 2) * kstep;
            const char* a3 = a2 + kstep; const char* b3 = b2 + kstep;
            if (last && has_next) S.a_ready(nxt);
            if constexpr (SP2) {
            PG8_LDB(B0, 0, 0); PG8_LDB(B1, 0, 1); PG8_SCHED; PG8_LDA(At, 0, 0); PG8_STAGE(PG8_SA(1, 1), a1 + hstep, voffA);
            PG8_WAIT_V(8); PG8_WAIT_L(0); PG8_BAR; PG8_MMA(0, 0, At, B0); PG8_MMA(0, 1, At, B1); PG8_BAR; PG8_SCHED;
            PG8_LDA(At, 0, 1); PG8_STAGE(PG8_SB(0, 0), b2, voffB); PG8_STAGE(PG8_SB(0, 1), b2 + hstep, voffB); PG8_STAGE(PG8_SA(0, 0), a2, voffA);
            PG8_WAIT_V(8); PG8_WAIT_L(0); PG8_BAR; PG8_MMA(1, 0, At, B0); PG8_MMA(1, 1, At, B1); PG8_BAR; PG8_SCHED;
            PG8_LDB(B0, 1, 0); PG8_LDB(B1, 1, 1); PG8_SCHED; PG8_LDA(At, 1, 0); PG8_STAGE(PG8_SA(0, 1), a2 + hstep, voffA);
            PG8_WAIT_V(8); PG8_WAIT_L(0); PG8_BAR; PG8_MMA(0, 0, At, B0); PG8_MMA(0, 1, At, B1); PG8_BAR; PG8_SCHED;
            PG8_LDA(At, 1, 1); PG8_STAGE(PG8_SB(1, 0), b3, voffB); PG8_STAGE(PG8_SB(1, 1), b3 + hstep, voffB); PG8_STAGE(PG8_SA(1, 0), a3, voffA);
            PG8_WAIT_V(8); PG8_WAIT_L(0); PG8_BAR; PG8_MMA(1, 0, At, B0); PG8_MMA(1, 1, At, B1); PG8_BAR; PG8_SCHED;
            } else {
            PG8_LDB(B0, 0, 0); PG8_SCHED; PG8_LDA(At, 0, 0); PG8_STAGE(PG8_SA(1, 1), a1 + hstep, voffA);
            PG8_WAIT_L(8); PG8_BAR; PG8_WAIT_L(0); PG8_MMA(0, 0, At, B0); PG8_BAR; PG8_SCHED;
            PG8_LDB(B1, 0, 1); PG8_STAGE(PG8_SB(0, 0), b2, voffB);
            PG8_BAR; PG8_WAIT_L(0); PG8_MMA(0, 1, At, B1); PG8_BAR;
            PG8_LDA(At, 0, 1); PG8_STAGE(PG8_SA(0, 0), a2, voffA);
            PG8_BAR; PG8_WAIT_L(0); PG8_MMA(1, 0, At, B0); PG8_BAR; PG8_SCHED;
            PG8_STAGE(PG8_SB(0, 1), b2 + hstep, voffB);
            PG8_WAIT_V(6); PG8_BAR; PG8_MMA(1, 1, At, B1); PG8_BAR;
            PG8_LDB(B0, 1, 0); PG8_SCHED; PG8_LDA(At, 1, 0); PG8_STAGE(PG8_SA(0, 1), a2 + hstep, voffA);
            PG8_WAIT_L(8); PG8_BAR; PG8_WAIT_L(0); PG8_MMA(0, 0, At, B0); PG8_BAR; PG8_SCHED;
            PG8_LDB(B1, 1, 1); PG8_STAGE(PG8_SB(1, 0), b3, voffB);
            PG8_BAR; PG8_WAIT_L(0); PG8_MMA(0, 1, At, B1); PG8_BAR;
            PG8_LDA(At, 1, 1); PG8_STAGE(PG8_SA(1, 0), a3, voffA);
            PG8_BAR; PG8_WAIT_L(0); PG8_MMA(1, 0, At, B0); PG8_BAR; PG8_SCHED;
            PG8_STAGE(PG8_SB(1, 1), b3 + hstep, voffB);
            PG8_WAIT_V(6); PG8_BAR; PG8_MMA(1, 1, At, B1); PG8_BAR;
            }
        }
        if constexpr (ALIGN_EPI) { if (wr == 0) PG8_BAR; }
        if constexpr (!Epi::AFTER_DRAIN) { E(acc, cur, wr, wc, fr, fq); S.done(cur); }
        if (!has_next) break;
#pragma unroll
        for (int a = 0; a < 2; ++a)
#pragma unroll
            for (int b = 0; b < 2; ++b)
#pragma unroll
                for (int m = 0; m < 4; ++m)
#pragma unroll
                    for (int n = 0; n < 2; ++n) acc[a][b][m][n] = (f32x4){0.f, 0.f, 0.f, 0.f};
        cur = nxt; cA = nA; cB = nB; ++ui;
        if constexpr (ALIGN_EPI) { if (wr == 1) PG8_BAR; }
    }
    PG8_WAIT_V(0);
    if constexpr (!ALIGN_EPI) { if (wr == 0) PG8_BAR; }
    PG8_BAR;
    if constexpr (Epi::AFTER_DRAIN) { E.fused(acc, cur, wr, wc, fr, fq, lds, wid, lane); S.done(cur); }
#undef PG8_SA
#undef PG8_SB
#undef PG8_STAGE
#undef PG8_LDA
#undef PG8_LDB
#undef PG8_MMA
#undef PG8_WAIT_V
#undef PG8_WAIT_L
#undef PG8_BAR
#undef PG8_SCHED
}
}
namespace att {
constexpr float SCALE = 0.08838834764831845f;
constexpr float THR = 8.f;
constexpr bool WSKIP = true;
constexpr int D = 128, NW = 8, QBLK = 32, KVBLK = 64, QB = NW * QBLK;
constexpr int SHM_V = KVBLK * D * 2, SHM_K = KVBLK * D * 2;
constexpr int ATT_LDS_BYTES = 2 * SHM_V + 2 * SHM_K + NW * 64 * 4;
constexpr int QS = 3072, KS = 3072, OS = 2048;
constexpr int WIN = 128, CTX_TILES = 4, CTXROW0 = 8192;

using bf16 = __hip_bfloat16;
typedef short bf16x8 __attribute__((ext_vector_type(8)));
typedef short s16x4 __attribute__((ext_vector_type(4)));
typedef float f32x16 __attribute__((ext_vector_type(16)));
typedef float f32x4 __attribute__((ext_vector_type(4)));
typedef unsigned u32x4 __attribute__((ext_vector_type(4)));
template <class A, class Bt> struct same_t { static constexpr bool v = false; };
template <class A> struct same_t<A, A> { static constexpr bool v = true; };

#define KSWZ(row, colB) ((row) * 256 + ((colB) ^ (((row) & 7) << 4)))
#define SBAR() __builtin_amdgcn_sched_barrier(0)
__device__ __forceinline__ int v_st(int k, int c) { const int kk = (k & ~0xC) | ((k & 4) << 1) | ((k & 8) >> 1); return ((kk >> 3) * 4 + (c >> 5)) * 512 + ((kk & 7) * 32 + (c & 31)) * 2; }
__device__ __forceinline__ int v_rd_base(int lane) { return ((lane & 3) << 3) | (((lane >> 2) & 3) << 6) | (((lane >> 4) & 1) << 5) | (((lane >> 5) & 1) << 8); }
constexpr int v_rd_off(int d0, int ks, int half) { return d0 * 512 + ks * 4096 + half * 2048; }
__device__ __forceinline__ int crow(int r, int hi) { return (r & 3) + 8 * (r >> 2) + 4 * hi; }
__device__ __forceinline__ unsigned cvtpk(float lo, float hi) {
    unsigned r; asm volatile("v_cvt_pk_bf16_f32 %0, %1, %2" : "=v"(r) : "v"(lo), "v"(hi)); return r;
}
__device__ __forceinline__ bf16x8 pack8(f32x4 a, f32x4 b) {
    u32x4 w = {cvtpk(a[0], a[1]), cvtpk(a[2], a[3]), cvtpk(b[0], b[1]), cvtpk(b[2], b[3])};
    return *reinterpret_cast<bf16x8*>(&w);
}
template <class T> __device__ __forceinline__ bf16x8 load8(const T* p) {
    if constexpr (same_t<T, float>::v) { return pack8(*(const f32x4*)p, *(const f32x4*)(p + 4)); }
    else { return *reinterpret_cast<const bf16x8*>(p); }
}
__device__ __forceinline__ void mask_tile(f32x16& p0, f32x16& p1, int dq, unsigned W) {
    const float NEG = -__builtin_inff();
#pragma unroll
    for (int r = 0; r < 16; ++r) {
        const int c = (r & 3) + 8 * (r >> 2);
        if ((unsigned)(dq - c) >= W) p0[r] = NEG;
        if ((unsigned)(dq - c - 32) >= W) p1[r] = NEG;
    }
}
__device__ __forceinline__ void partialSM(f32x16& p0, f32x16& p1, float& m_reg, float& mn, float& alpha) {
    float pmax = p0[0]; for (int r = 1; r < 16; ++r) pmax = fmaxf(pmax, p0[r]); for (int r = 0; r < 16; ++r) pmax = fmaxf(pmax, p1[r]);
    { auto rr = __builtin_amdgcn_permlane32_swap(__float_as_uint(pmax), __float_as_uint(pmax), false, false);
      pmax = fmaxf(__uint_as_float(rr[0]), __uint_as_float(rr[1])); }
    constexpr float C2 = 1.4426950408889634f * SCALE;
    if (__builtin_expect(__all((pmax - m_reg) * SCALE <= THR), 1)) { mn = m_reg; alpha = 1.f; }
    else { mn = fmaxf(m_reg, pmax); alpha = __builtin_amdgcn_exp2f((m_reg - mn) * C2); m_reg = mn; }
    const float mnL = -mn * C2;
    for (int r = 0; r < 16; ++r) p0[r] = fmaf(p0[r], C2, mnL); for (int r = 0; r < 16; ++r) p1[r] = fmaf(p1[r], C2, mnL);
    for (int r = 0; r < 16; ++r) p0[r] = __builtin_amdgcn_exp2f(p0[r]);
}
__device__ __forceinline__ void finishSM(f32x16& p0, f32x16& p1, float alpha, float& l_reg, bf16x8& pa0, bf16x8& pa1, bf16x8& pa2, bf16x8& pa3) {
    for (int r = 0; r < 16; ++r) p1[r] = __builtin_amdgcn_exp2f(p1[r]);
    float ps = 0; for (int r = 0; r < 16; ++r) ps += p0[r]; for (int r = 0; r < 16; ++r) ps += p1[r];
    { auto rr = __builtin_amdgcn_permlane32_swap(__float_as_uint(ps), __float_as_uint(ps), false, false);
      ps = __uint_as_float(rr[0]) + __uint_as_float(rr[1]); }
    l_reg = l_reg * alpha + ps;
#define PK4(P, B_, OUT) do { unsigned a0 = cvtpk(P[B_+0], P[B_+1]), a1 = cvtpk(P[B_+2], P[B_+3]);                          \
        unsigned b0 = cvtpk(P[B_+4], P[B_+5]), b1 = cvtpk(P[B_+6], P[B_+7]);                                             \
        auto r0 = __builtin_amdgcn_permlane32_swap(a0, b0, false, false); auto r1 = __builtin_amdgcn_permlane32_swap(a1, b1, false, false); \
        u32x4 w = {r0[0], r1[0], r0[1], r1[1]}; OUT = *reinterpret_cast<bf16x8*>(&w); } while (0)
    PK4(p0, 0, pa0); PK4(p0, 8, pa1); PK4(p1, 0, pa2); PK4(p1, 8, pa3);
#undef PK4
}
template <int KB, bool SK>
__device__ __forceinline__ void qkt(f32x16& p0, f32x16& p1, const char* K_lds, int r32, int hi, const bf16x8* qr, bool act) {
    if (SK && !act) { const float NEG = -__builtin_inff();
#pragma unroll
        for (int r = 0; r < 16; ++r) { p0[r] = NEG; p1[r] = NEG; } return; }
    p0 = f32x16{}; p1 = f32x16{};
    const char* kb[4];
#pragma unroll
    for (int dd = 0; dd < 4; ++dd) kb[dd] = K_lds + KB * SHM_K + KSWZ(r32, (dd * 16 + hi * 8) * 2);
#pragma unroll
    for (int d0 = 0; d0 < 8; ++d0) { const char* a = kb[d0 & 3] + (d0 >> 2) * 128;
        bf16x8 b0 = *reinterpret_cast<const bf16x8*>(a);
        bf16x8 b1 = *reinterpret_cast<const bf16x8*>(a + 32 * 256);
        p0 = __builtin_amdgcn_mfma_f32_32x32x16_bf16(b0, qr[d0], p0, 0, 0, 0);
        p1 = __builtin_amdgcn_mfma_f32_32x32x16_bf16(b1, qr[d0], p1, 0, 0, 0); }
}
template <int VB, bool SK>
__device__ __forceinline__ void pv_tile(f32x16* o, int vb0, bf16x8 pa0, bf16x8 pa1, bf16x8 pa2, bf16x8 pa3, bool act) {
    if (SK && !act) return;
#define TRRD(dst, off) asm volatile("ds_read_b64_tr_b16 %0, %1 offset:%2" : "=&v"(dst) : "v"(vb0), "i"(off) : "memory")
#define PV_D0(d0) do { s16x4 l0, l1, l2, l3, h0, h1, h2, h3; constexpr int b_ = VB * SHM_V + v_rd_off(d0, 0, 0);     \
        TRRD(l0, b_); TRRD(h0, b_ + 2048); TRRD(l1, b_ + 4096); TRRD(h1, b_ + 6144); TRRD(l2, b_ + 8192); TRRD(h2, b_ + 10240); TRRD(l3, b_ + 12288); TRRD(h3, b_ + 14336); \
        asm volatile("s_waitcnt lgkmcnt(0)" ::: "memory"); SBAR();                 \
        o[d0] = __builtin_amdgcn_mfma_f32_32x32x16_bf16(pa0, (bf16x8){l0[0], l0[1], l0[2], l0[3], h0[0], h0[1], h0[2], h0[3]}, o[d0], 0, 0, 0);   \
        o[d0] = __builtin_amdgcn_mfma_f32_32x32x16_bf16(pa1, (bf16x8){l1[0], l1[1], l1[2], l1[3], h1[0], h1[1], h1[2], h1[3]}, o[d0], 0, 0, 0);   \
        o[d0] = __builtin_amdgcn_mfma_f32_32x32x16_bf16(pa2, (bf16x8){l2[0], l2[1], l2[2], l2[3], h2[0], h2[1], h2[2], h2[3]}, o[d0], 0, 0, 0);   \
        o[d0] = __builtin_amdgcn_mfma_f32_32x32x16_bf16(pa3, (bf16x8){l3[0], l3[1], l3[2], l3[3], h3[0], h3[1], h3[2], h3[3]}, o[d0], 0, 0, 0); } while (0)
    PV_D0(0); PV_D0(1); PV_D0(2); PV_D0(3);
#undef PV_D0
#undef TRRD
}

template <class TIn, class TOut> struct BlockRef { const TIn* Q; const TIn* K; const TIn* V; TOut* O; int P0; int jlo, ntb; float m0; };
template <class TIn, class TOut> __device__ __forceinline__ int krow0(const BlockRef<TIn, TOut>& b) { return b.ntb > 0 ? b.jlo * KVBLK : CTXROW0; }
template <class TIn> struct Seam {
    bf16x8 qr[8];
    bf16x8 st_v0, st_v1, st_k0, st_k1; f32x4 sf0, sf1, sf2, sf3;
    f32x4 tq[16];
};
__device__ __forceinline__ int swa_jlo(int P0, int W) { const int lowk = P0 - W + 1; return lowk > 0 ? lowk / KVBLK : 0; }
#define ROW(p, k0, rr) ((p) + (size_t)((k0) + (rr)) * KS + sc)
#define VMW() asm volatile("s_waitcnt vmcnt(0)" ::: "memory")
#define VMWN(n) asm volatile("s_waitcnt vmcnt(%0)" :: "i"(n) : "memory")
#define SLOAD_H(Kp, Vp, k0) do { S.st_v0 = load8<TIn>(ROW(Vp, k0, sr)); S.st_v1 = load8<TIn>(ROW(Vp, k0, 32 + sr));              \
                         S.st_k0 = load8<TIn>(ROW(Kp, k0, sr)); S.st_k1 = load8<TIn>(ROW(Kp, k0, 32 + sr)); } while (0)
#define SWRITE_HK(bf) do { *(bf16x8*)(K_lds + (bf) * SHM_K + kws) = S.st_k0; *(bf16x8*)(K_lds + (bf) * SHM_K + kws + 32 * 256) = S.st_k1; } while (0)
#define SWRITE_HV(bf) do { *(bf16x8*)(V_lds + (bf) * SHM_V + vst0) = S.st_v0; *(bf16x8*)(V_lds + (bf) * SHM_V + vst1) = S.st_v1; } while (0)
#define SWRITE_H(bf) do { SWRITE_HV(bf); SWRITE_HK(bf); } while (0)
#define SLOAD_F(p, k0) do { S.sf0 = *(const f32x4*)ROW(p, k0, sr); S.sf1 = *(const f32x4*)(ROW(p, k0, sr) + 4);                \
                            S.sf2 = *(const f32x4*)ROW(p, k0, 32 + sr); S.sf3 = *(const f32x4*)(ROW(p, k0, 32 + sr) + 4); } while (0)
#define SWRITE_KF(bf) do { *(bf16x8*)(K_lds + (bf) * SHM_K + kws) = pack8(S.sf0, S.sf1); *(bf16x8*)(K_lds + (bf) * SHM_K + kws + 32 * 256) = pack8(S.sf2, S.sf3); } while (0)
#define SWRITE_VF(bf) do { *(bf16x8*)(V_lds + (bf) * SHM_V + vst0) = pack8(S.sf0, S.sf1); *(bf16x8*)(V_lds + (bf) * SHM_V + vst1) = pack8(S.sf2, S.sf3); } while (0)
template <class TIn, class TOut>
__device__ __forceinline__ void causal_swa_prime(const BlockRef<TIn, TOut>& cur, char* lds, Seam<TIn>& S, const int wv) {
    constexpr bool F32 = same_t<TIn, float>::v;
    int tid_ = (wv << 6) | hw_lane(); asm volatile("" : "+v"(tid_));
    const int tid = tid_, wid = __builtin_amdgcn_readfirstlane(tid >> 6), lane = tid & 63, r32 = lane & 31, hi = lane >> 5;
    const int sr = tid >> 4, sc = (tid & 15) * 8, kws = KSWZ(sr, sc * 2); char* K_lds = lds + 2 * SHM_V;
    const int kb0 = krow0(cur);
    for (int d0 = 0; d0 < 8; ++d0) S.qr[d0] = load8<TIn>(cur.Q + (size_t)(wid * QBLK + r32) * QS + d0 * 16 + hi * 8);
    if constexpr (F32) { SLOAD_F((const float*)cur.K, kb0); VMW(); SWRITE_KF(0); SBAR(); SLOAD_F((const float*)cur.V, kb0); }
    else { SLOAD_H(cur.K, cur.V, kb0); VMW(); SWRITE_HK(0); }
    __syncthreads();
}
template <class TIn, class TOut>
__device__ __forceinline__ void causal_swa_block(const BlockRef<TIn, TOut>& cur, const BlockRef<TIn, TOut>& nxt, char* lds, Seam<TIn>& S, const int wv) {
    constexpr bool F32 = same_t<TIn, float>::v;
    int tid_ = (wv << 6) | hw_lane(); asm volatile("" : "+v"(tid_));
    const int tid = tid_, wid = __builtin_amdgcn_readfirstlane(tid >> 6), lane = tid & 63, r32 = lane & 31, hi = lane >> 5;
    const int j_lo = cur.jlo, NTB = cur.ntb;
    const int NT = NTB + CTX_TILES;
    const int kbn = krow0(nxt);
    const int qlo = cur.P0 + wid * QBLK, qm = qlo + r32 - 4 * hi;
    char* V_lds = lds; char* K_lds = lds + 2 * SHM_V;
    float* ws = (float*)(lds + 2 * SHM_V + 2 * SHM_K) + wid * 64; float* li_l = ws, * al_l = ws + 32;
    float m_reg = cur.m0, l_reg = 1.f; f32x16 o[4] = {};
    const int sr = tid >> 4, sc = (tid & 15) * 8, vst0 = v_st(sr, sc), vst1 = v_st(32 + sr, sc), kws = KSWZ(sr, sc * 2);
    const int vb0 = (int)(uintptr_t)V_lds + v_rd_base(lane);
    const TIn* Kh = cur.K; const TIn* Vh = cur.V;
#define RESC(a) do { if (__any((a) < 1.f)) { if (hi == 0) al_l[r32] = (a); asm volatile("s_waitcnt lgkmcnt(0)" ::: "memory");              \
                     for (int d_ = 0; d_ < 4; ++d_) for (int r = 0; r < 16; ++r) o[d_][r] *= al_l[crow(r, hi)]; } } while (0)
#define KBASE(t) ((j_lo + (t)) * KVBLK)
#define KROW(t) (((t) < NTB) ? KBASE(t) : CTXROW0 + ((t) - NTB) * KVBLK)
#define ACT(t) ((t) >= NTB || (KBASE(t) <= qlo + QBLK - 1 + WIN && KBASE(t) + KVBLK - 1 >= qlo - WIN))
#define MASKT(P0_, P1_, t) do { const int kb_ = KBASE(t); if ((t) < NTB && (!SK || ACT(t)) && (kb_ + KVBLK - 1 > qlo + WIN || kb_ < qlo + QBLK - 1 - WIN)) mask_tile(P0_, P1_, qm - kb_ + WIN, (unsigned)(2 * WIN + 1)); } while (0)
    constexpr int NQL = F32 ? 16 : 8;
    constexpr bool SK = WSKIP && !F32;
#define SEAM_K0() do { VMWN(NQL); if constexpr (F32) { SWRITE_KF(0); SBAR(); SLOAD_F((const float*)nxt.V, kbn); } else { SWRITE_HK(0); } SBAR(); } while (0)
    f32x16 pA0, pA1, pB0, pB1; float mnA, mnB, alA, alB; bf16x8 pa0, pa1, pa2, pa3;
    if constexpr (F32) { VMW(); SWRITE_VF(0); SBAR(); } else { SWRITE_HV(0); SBAR(); }
    if (NT > 1) { if constexpr (F32) SLOAD_F((const float*)Kh, KROW(1)); else SLOAD_H(Kh, Vh, KROW(1)); }
    SBAR(); qkt<0, SK>(pA0, pA1, K_lds, r32, hi, S.qr, ACT(0));
    if constexpr (F32) { if (NT > 1) { VMW(); SWRITE_KF(1); SBAR(); SLOAD_F((const float*)Vh, KROW(1)); } }
    MASKT(pA0, pA1, 0); partialSM(pA0, pA1, m_reg, mnA, alA);
    if (NT > 1) { VMW(); if constexpr (F32) { SWRITE_VF(1); SBAR(); if (NT > 2) SLOAD_F((const float*)Kh, KROW(2)); } else SWRITE_H(1); }
    __syncthreads();
#define HALF_STEP(PX0, PX1, mnX, alX, PY0, PY1, alY, t, KB, VB, SB) do {                                                      \
        SBAR(); qkt<KB, SK>(PX0, PX1, K_lds, r32, hi, S.qr, ACT(t));                                             \
        finishSM(PY0, PY1, alY, l_reg, pa0, pa1, pa2, pa3); SBAR();                                                           \
        if ((t) + 1 < NT) { if constexpr (F32) { VMW(); SWRITE_KF(SB); SBAR(); SLOAD_F((const float*)Vh, KROW((t) + 1)); }  \
                            else { SLOAD_H(Kh, Vh, KROW((t) + 1)); } SBAR(); }                                               \
        pv_tile<VB, SK>(o, vb0, pa0, pa1, pa2, pa3, ACT((t) - 1)); MASKT(PX0, PX1, (t)); partialSM(PX0, PX1, m_reg, mnX, alX);                                        \
        __syncthreads();                                                                                                      \
        if ((t) + 1 < NT) { VMW(); if constexpr (F32) { SWRITE_VF(SB); SBAR(); if ((t) + 2 < NT) SLOAD_F((const float*)Kh, KROW((t) + 2)); } \
                            else { SWRITE_H(SB); } }                                                                          \
        RESC(alX); __syncthreads(); } while (0)
    for (int t = 1; t + 1 < NT; t += 2) {
        HALF_STEP(pB0, pB1, mnB, alB, pA0, pA1, alA, t, 1, 0, 0);
        HALF_STEP(pA0, pA1, mnA, alA, pB0, pB1, alB, t + 1, 0, 1, 1);
    }
    const bool even = (NT & 1) == 0;
    if (even) { SBAR(); qkt<1, SK>(pB0, pB1, K_lds, r32, hi, S.qr, ACT(NT - 1)); SBAR(); }
#define QROW(e) (nxt.Q + (size_t)(wid * QBLK + r32) * QS + ((e) >> 1) * 16 + hi * 8 + ((e) & 1) * 4)
    if constexpr (F32) { SLOAD_F((const float*)nxt.K, kbn); SBAR();
#pragma unroll
        for (int e = 0; e < 8; ++e) S.tq[e] = *(const f32x4*)QROW(e); }
    else { SLOAD_H(nxt.K, nxt.V, kbn); SBAR();
#pragma unroll
        for (int d0 = 0; d0 < 8; ++d0) S.qr[d0] = load8<TIn>(nxt.Q + (size_t)(wid * QBLK + r32) * QS + d0 * 16 + hi * 8); }
    SBAR();
    finishSM(pA0, pA1, alA, l_reg, pa0, pa1, pa2, pa3); SBAR();
    if constexpr (F32) {
#pragma unroll
        for (int e = 8; e < 16; ++e) S.tq[e] = *(const f32x4*)QROW(e); SBAR(); }
#undef QROW
    pv_tile<0, SK>(o, vb0, pa0, pa1, pa2, pa3, ACT(even ? NT - 2 : NT - 1));
    if (even) { MASKT(pB0, pB1, NT - 1); partialSM(pB0, pB1, m_reg, mnB, alB); __syncthreads(); RESC(alB);
        finishSM(pB0, pB1, alB, l_reg, pa0, pa1, pa2, pa3); SBAR(); pv_tile<1, SK>(o, vb0, pa0, pa1, pa2, pa3, ACT(NT - 1)); }
    SBAR(); SEAM_K0();
    if (hi == 0) li_l[r32] = l_reg; asm volatile("s_waitcnt lgkmcnt(0)" ::: "memory");
    float rli[16];
#pragma unroll
    for (int r = 0; r < 16; ++r) rli[r] = __builtin_amdgcn_rcpf(li_l[crow(r, hi)]);
    int r32o = r32, hio = hi; asm volatile("" : "+v"(r32o), "+v"(hio));
    char* Owb = (char*)(cur.O + (size_t)(wid * QBLK) * OS);
#pragma unroll
    for (int r = 0; r < 16; ++r) { const unsigned ooff = (unsigned)((crow(r, hio) * OS + r32o) * 2);
#pragma unroll
        for (int d0 = 0; d0 < 4; ++d0) { const float v = o[d0][r] * rli[r];
            if constexpr (same_t<TOut, float>::v) { static_assert(!same_t<TOut, float>::v, "bf16 O only"); }
            else { const float vn = __int_as_float(__builtin_amdgcn_mov_dpp(__float_as_int(v), 0xB1, 0xF, 0xF, true));
                   if ((r32o & 1) == 0) *(unsigned*)(Owb + ooff + d0 * 64) = cvtpk(v, vn); } } }
    if constexpr (F32) {
#pragma unroll
        for (int d0 = 0; d0 < 8; ++d0) S.qr[d0] = pack8(S.tq[2 * d0], S.tq[2 * d0 + 1]); }
    __syncthreads();
#undef RESC
#undef KBASE
#undef KROW
#undef ACT
#undef MASKT
#undef SEAM_K0
#undef HALF_STEP
}
#undef ROW
#undef VMW
#undef VMWN
#undef SLOAD_H
#undef SWRITE_HK
#undef SWRITE_HV
#undef SWRITE_H
#undef SLOAD_F
#undef SWRITE_KF
#undef SWRITE_VF
}
constexpr int DM = 2048, SEQ = 8192, CTXL = 256, MR = SEQ + CTXL, DEPTH = 4, HDIM = 128, NHQ = 16, NHKV = 4;
constexpr int NQKV = 3072, DFF = 5632, NUP = 2 * DFF, NIN = 3 * DM, NADA = 6 * DM;
constexpr float RMS_EPS = 1e-6f;
constexpr int NWAVES = 8;

constexpr size_t MiB = 1u << 20;
constexpr size_t WS_CTL = 0, CTL_ZERO_BYTES = 1 * MiB;
constexpr size_t WS_MOD = 1 * MiB;
constexpr size_t WS_ROPE = WS_MOD + 512 * 1024;
constexpr size_t SZ_WQKV = (size_t)NQKV * DM * 2, SZ_WO = (size_t)DM * DM * 2, SZ_WIN = (size_t)NIN * DM * 2, SZ_WUP = (size_t)NUP * DM * 2, SZ_WDN = (size_t)DM * DFF * 2;
constexpr size_t WS_WQKV = 2 * MiB, WS_WO = WS_WQKV + 2 * SZ_WQKV, WS_WIN = WS_WO + 2 * SZ_WO, WS_WOUT = WS_WIN + 2 * SZ_WIN, WS_WUP = WS_WOUT + 2 * SZ_WO, WS_WDN = WS_WUP + 4 * SZ_WUP;
constexpr size_t WS_XR = WS_WDN + 4 * SZ_WDN;
constexpr size_t WS_HN = WS_XR + (size_t)MR * DM * 4;
constexpr int HN_LAT0 = 1, HN_CTX0 = SEQ + 2;
constexpr size_t WS_R1 = WS_HN + (size_t)(MR + 8) * DM * 2;
constexpr size_t WS_GV = WS_R1, WS_QKV = WS_R1, WS_AO = WS_R1 + (size_t)MR * NQKV * 2, WS_BCV = WS_R1, WS_Z = WS_R1 + (size_t)MR * NIN * 2;
constexpr size_t WS_U = WS_R1 + (size_t)MR * NUP * 2;
constexpr size_t WS_BG1 = WS_U + (size_t)MR * DFF * 2, SZ_BG1 = (size_t)4 * 2 * NIN * 4, WS_BUP = WS_BG1 + DEPTH * SZ_BG1, SZ_BUP = (size_t)4 * 2 * NUP * 4;
constexpr size_t WS_END = WS_BUP + DEPTH * SZ_BUP;
constexpr int CW_BAR = 4096;
constexpr size_t CTL_ROWSS = 64 * 1024;
static_assert(CTL_ROWSS + (size_t)8 * MR * 4 <= CTL_ZERO_BYTES, "CTL map");

constexpr int RING_OFF = 0, RING_BYTES = 131072;
constexpr int LDSCTL_OFF = RING_BYTES, MISC_OFF = LDSCTL_OFF + 320;
constexpr int XCH_OFF = MISC_OFF + 128, XCH_BYTES = 4096;
constexpr int LDS_BYTES = 147456;
static_assert(XCH_OFF % 16 == 0 && XCH_OFF + XCH_BYTES <= LDS_BYTES, "LDS map");

#define GAS __attribute__((address_space(1)))
#define LAS __attribute__((address_space(3)))
typedef unsigned short bf16;
typedef unsigned v4u __attribute__((ext_vector_type(4)));
typedef unsigned v2u __attribute__((ext_vector_type(2)));
typedef float f32x4 __attribute__((ext_vector_type(4)));
typedef GAS unsigned gu32;
#define RLX_AGENT __ATOMIC_RELAXED, __HIP_MEMORY_SCOPE_AGENT
#define LDS_WAIT() asm volatile("s_waitcnt lgkmcnt(0)" ::: "memory")
__device__ __forceinline__ unsigned pk2(float lo, float hi) { return pg8::cvt_pk_bf16(lo, hi); }
__device__ __forceinline__ float bf_lo(unsigned w) { return __uint_as_float(w << 16); }
__device__ __forceinline__ float bf_hi(unsigned w) { return __uint_as_float(w & 0xffff0000u); }

#define XB_TMO      128
#define XB_XCNT(j)  (256  + 64 * (j))
#define XB_XSUB(j)  (1280 + 64 * (j))
#define XB_XGEN(j)  (2304 + 64 * (j))
#define XB_TOP      3328
#define XB_TOPGEN   3392
#define XCD_BAR_WORDS 3456
#define XB_SPIN_CAP (1u << 18)

__device__ __forceinline__ unsigned xb_ld(unsigned* p)              { return __hip_atomic_load(p, __ATOMIC_RELAXED, __HIP_MEMORY_SCOPE_AGENT); }
__device__ __forceinline__ unsigned xb_add(unsigned* p, unsigned v) { return __hip_atomic_fetch_add(p, v, __ATOMIC_RELAXED, __HIP_MEMORY_SCOPE_AGENT); }
__device__ __forceinline__ unsigned xb_xcc_id() { return (unsigned)__builtin_amdgcn_s_getreg((3 << 11) | 20) & 0xFu; }
#define XB_SPIN(cond, bar) do { unsigned _sp = 0; while (cond) { __builtin_amdgcn_s_sleep(1); \
    if ((++_sp & 255u) == 0u) { if (xb_ld(&(bar)[XB_TMO])) break; if (_sp > XB_SPIN_CAP) { atomicAdd(&(bar)[XB_TMO], 1u); break; } } } } while (0)

struct XcdBarrier {
    unsigned* bar; unsigned x;
    volatile LAS unsigned* st;
};
__device__ __forceinline__ XcdBarrier xcd_barrier_post(unsigned* bar, volatile LAS unsigned* st, const bool t0  ) {
    XcdBarrier b; b.bar = bar; b.x = xb_xcc_id(); b.st = st;
    if (t0) (void)xb_add(&bar[XB_XCNT(b.x)], 1u);
    return b;
}
__device__ __forceinline__ void xcd_barrier_complete(unsigned* bar, unsigned x, unsigned& nloc, unsigned& nx) {
    const unsigned G = gridDim.x * gridDim.y * gridDim.z;
    unsigned sum, cnt, mine, sp = 0u;
    for (;;) {
        sum = 0u; cnt = 0u; mine = 0u;
#pragma unroll
        for (unsigned j = 0; j < 16; ++j) { const unsigned c = xb_ld(&bar[XB_XCNT(j)]); sum += c; cnt += (c > 0u) ? 1u : 0u; mine = (j == x) ? c : mine; }
        if (sum == G) break;
        __builtin_amdgcn_s_sleep(1);
        if ((++sp & 255u) == 0u) { if (xb_ld(&bar[XB_TMO])) break; if (sp > XB_SPIN_CAP) { atomicAdd(&bar[XB_TMO], 1u); break; } }
    }
    nloc = mine > 0u ? mine : 1u; nx = cnt > 0u ? cnt : 1u;
}
__device__ __forceinline__ void xcd_barrier(const XcdBarrier& b, const int wv) {
    asm volatile("s_waitcnt vmcnt(0)" ::: "memory");
    __syncthreads();
    if (wv == 0 && hw_lane() == 0) {
        unsigned long long bar_i = (unsigned long long)b.bar; asm volatile("" : "+s"(bar_i));
        unsigned* bar = (unsigned*)(GAS unsigned*)bar_i;
        __builtin_amdgcn_s_waitcnt(0);
        unsigned nloc = b.st[0], nx = b.st[1];
        if (nloc == 0u) { xcd_barrier_complete(bar, b.x, nloc, nx); b.st[0] = nloc; b.st[1] = nx; }
        const unsigned old = xb_add(&bar[XB_XSUB(b.x)], 1u);
        const unsigned gen = old / nloc;
        if (old + 1u == (gen + 1u) * nloc) {
            __builtin_amdgcn_fence(__ATOMIC_RELEASE, "agent");
            asm volatile("s_waitcnt vmcnt(0)" ::: "memory");
            const unsigned og = xb_add(&bar[XB_TOP], 1u);
            const unsigned tg = og / nx;
            if (og + 1u == (tg + 1u) * nx) xb_add(&bar[XB_TOPGEN], 1u);
            else XB_SPIN(xb_ld(&bar[XB_TOPGEN]) == tg, bar);
            __builtin_amdgcn_fence(__ATOMIC_ACQUIRE, "agent");
            xb_add(&bar[XB_XGEN(b.x)], 1u);
            asm volatile("s_waitcnt vmcnt(0)" ::: "memory");
        } else {
            XB_SPIN(xb_ld(&bar[XB_XGEN(b.x)]) == gen, bar);
            __builtin_amdgcn_fence(__ATOMIC_ACQUIRE, "agent");
            asm volatile("s_waitcnt vmcnt(0)" ::: "memory");
        }
    }
    __syncthreads();
}

struct Frame {
    LAS unsigned char* lds; char* ldsg;
    volatile LAS unsigned* MISC;
    unsigned char* ws;
    int vcu, G;
    int wv;
    float* out;
};
__device__ __forceinline__ const float* inptr(const Frame& F, int i) {
    const LAS unsigned* t = (const LAS unsigned*)(F.lds + LDSCTL_OFF + 64) + 2 * i;
    const unsigned lo = __builtin_amdgcn_readfirstlane(t[0]), hi = __builtin_amdgcn_readfirstlane(t[1]);
    return (const float*)(const GAS float*)(((unsigned long long)hi << 32) | lo);
}
#define PHASE_IDS int tid_ = (F.wv << 6) | hw_lane(); asm volatile("" : "+v"(tid_)); const int tid = tid_, lane = tid & 63, wave = __builtin_amdgcn_readfirstlane(tid >> 6); (void)lane; (void)wave
template <int CTRL> __device__ __forceinline__ float dppf(float v) { return __int_as_float(__builtin_amdgcn_mov_dpp(__float_as_int(v), CTRL, 0xF, 0xF, true)); }
#define DPP_XOR1 0xB1
#define DPP_XOR2 0x4E
#define DPP_HMIRROR 0x141
#define DPP_MIRROR 0x140
__device__ __forceinline__ float row16_sum(float v) {
    v += dppf<DPP_XOR1>(v); v += dppf<DPP_XOR2>(v); v += dppf<DPP_HMIRROR>(v); v += dppf<DPP_MIRROR>(v); return v;
}
template <int PAT> __device__ __forceinline__ float swz_xor(float v) { return __int_as_float(__builtin_amdgcn_ds_swizzle(__float_as_int(v), PAT)); }
__device__ __forceinline__ float wave_sum(float v) {
    v = row16_sum(v); v += swz_xor<0x401F>(v);
    const auto rr = __builtin_amdgcn_permlane32_swap(__float_as_uint(v), __float_as_uint(v), false, false);
    return __uint_as_float(rr[0]) + __uint_as_float(rr[1]);
}
__device__ __forceinline__ float silu_f(float x) { return x / (1.f + __expf(-x)); }

template <bool GLU_PERM, bool BIAS>
__device__ __forceinline__ float p0_transpose_item(const float* W, int K, int N, bf16* WT, LAS float* scr, int kb, int nb, int lane, const LAS float* shv = nullptr) {
    const int k0 = 64 * kb, n0 = 32 * nb;
    const int d0 = GLU_PERM ? ((n0 % DFF) / 128) * 256 + (n0 >= DFF ? 128 : 0) + (n0 % DFF) % 128 : n0;
#pragma unroll 8
    for (int i = 0; i < 32; ++i) { const int kk = 2 * i + (lane >> 5); scr[kk * 33 + (lane & 31)] = W[(size_t)(k0 + kk) * N + n0 + (lane & 31)]; }
    LDS_WAIT(); asm volatile("" ::: "memory");
    const int c = lane & 7;
#pragma unroll
    for (int j = 0; j < 4; ++j) { const int n = (lane >> 3) + 8 * j; const LAS float* s = scr + (8 * c) * 33 + n;
        v4u o; o.x = pk2(s[0 * 33], s[1 * 33]); o.y = pk2(s[2 * 33], s[3 * 33]); o.z = pk2(s[4 * 33], s[5 * 33]); o.w = pk2(s[6 * 33], s[7 * 33]);
        *(GAS v4u*)(WT + (size_t)(d0 + n) * K + k0 + 8 * c) = o; }
    float p = 0.f;
    if (BIAS) { const int sidx = lane >> 5, nn = lane & 31; const LAS float* sh = shv + sidx * DM + k0;
#pragma unroll 16
        for (int kk = 0; kk < 64; ++kk) p += sh[kk] * scr[kk * 33 + nn]; }
    LDS_WAIT(); asm volatile("" ::: "memory");
    return p;
}

__device__ __forceinline__ void p0a_phase(Frame& F) {
    PHASE_IDS;
    {
        LAS float* sact = (LAS float*)(F.lds);
        LAS float* red = (LAS float*)(F.lds + 16384);
        const float* cv = inptr(F, 1); const float* ccv = inptr(F, 3);
        for (int k = tid; k < DM; k += NWAVES * 64) { sact[k] = silu_f(cv[k]); sact[DM + k] = silu_f(ccv[k]); }
        __syncthreads();
        float* mod = (float*)(F.ws + WS_MOD);
        const int col4 = tid % 48, rg = tid / 48;
        for (int u = F.vcu; u < DEPTH * 64; u += F.G) {
            const int l = u >> 6, c0 = (u & 63) * 192;
            if (rg < 10) {
                f32x4 a0 = {0.f, 0.f, 0.f, 0.f}, a1 = {0.f, 0.f, 0.f, 0.f};
                const float* wp = inptr(F, 4) + (size_t)l * DM * NADA + c0 + 4 * col4;
#pragma unroll 8
                for (int k = rg; k < DM; k += 10) { const f32x4 w = *(const f32x4*)(wp + (size_t)k * NADA); const float s0 = sact[k], s1 = sact[DM + k]; a0 += w * s0; a1 += w * s1; }
                *(LAS f32x4*)(red + (rg * 2 + 0) * 192 + 4 * col4) = a0; *(LAS f32x4*)(red + (rg * 2 + 1) * 192 + 4 * col4) = a1;
            }
            __syncthreads();
            if (tid < 384) { const int sI = tid / 192, jj = tid % 192; float sum = 0.f;
#pragma unroll
                for (int r = 0; r < 10; ++r) sum += red[(r * 2 + sI) * 192 + jj];
                mod[(size_t)(l * 2 + sI) * NADA + c0 + jj] = sum + inptr(F, 5)[l * NADA + c0 + jj]; }
            __syncthreads();
        }
    }
    {
        float2* rt = (float2*)(F.ws + WS_ROPE);
        for (int i = F.vcu * (NWAVES * 64) + tid; i < 192 * 32; i += F.G * NWAVES * 64) {
            const int q = i >> 5, p = i & 31, pos = q < 128 ? q : q - 128;
            const float inv = exp2f(-(float)p * (13.287712379549449f / 32.f));
            const float ang = (float)pos * inv;
            rt[i] = make_float2(__cosf(ang), __sinf(ang));
        }
    }
    if (F.vcu == 0) { v4u* z0 = (v4u*)(F.ws + WS_HN); v4u* z1 = (v4u*)(F.ws + WS_HN + (size_t)(SEQ + 1) * DM * 2); const v4u zz = {0u, 0u, 0u, 0u};
        for (int i = tid; i < DM * 2 / 16; i += NWAVES * 64) { z0[i] = zz; z1[i] = zz; } }
}

__device__ __forceinline__ void p0b_phase(Frame& F) {
    PHASE_IDS;
    const float* mod = (const float*)(F.ws + WS_MOD);
    {
        const int gw = F.vcu * NWAVES + wave, NGW = F.G * NWAVES;
        bf16* HN = (bf16*)(F.ws + WS_HN); float* rowss = (float*)(F.ws + WS_CTL + CTL_ROWSS);
        for (int m = gw; m < MR; m += NGW) {
            const float* md = mod + (m >= SEQ ? NADA : 0) + DM;
            const f32x4* xr = (const f32x4*)(m < SEQ ? inptr(F, 0) + (size_t)m * DM : inptr(F, 2) + (size_t)(m - SEQ) * DM) + lane;
            f32x4 v[8]; float ssum = 0.f;
#pragma unroll
            for (int j = 0; j < 8; ++j) { v[j] = xr[64 * j]; ssum += (v[j].x * v[j].x + v[j].y * v[j].y) + (v[j].z * v[j].z + v[j].w * v[j].w); }
            ssum = wave_sum(ssum);
            if (lane == 0) rowss[m] = ssum;
            v2u* o8 = (v2u*)(HN + (size_t)(m < SEQ ? HN_LAT0 + m : HN_CTX0 + (m - SEQ)) * DM) + lane;
#pragma unroll
            for (int j = 0; j < 8; ++j) { const f32x4 sc = ((const f32x4*)md)[lane + 64 * j]; const f32x4 o = v[j] * (1.f + sc); v2u w; w.x = pk2(o.x, o.y); w.y = pk2(o.z, o.w); o8[64 * j] = w; }
        }
    }
    {
        LAS float* scr = (LAS float*)(F.lds + RING_OFF + wave * 12288);
        LAS float* shv = (LAS float*)(F.lds + RING_OFF + 8 * 12288);
        constexpr int U_QKV = (NQKV / 256) * (DM / 512), U_O = (DM / 256) * (DM / 512), U_IN = (NIN / 256) * (DM / 512), U_UP = (NUP / 256) * (DM / 512), U_DN = (DM / 256) * (DFF / 512);
        constexpr int NUNITS = 2 * (U_QKV + U_O + U_IN + U_O) + 4 * (U_UP + U_DN);
        float* bg1 = (float*)(F.ws + WS_BG1); float* bup = (float*)(F.ws + WS_BUP);
        int cur_mat = -1;
        for (int un = F.vcu; un < NUNITS; un += F.G) {
            int r = un, mt, j;
            if (r < 2 * U_QKV) { mt = 0; j = r / U_QKV; r %= U_QKV; }
            else if ((r -= 2 * U_QKV) < 2 * U_O) { mt = 1; j = r / U_O; r %= U_O; }
            else if ((r -= 2 * U_O) < 2 * U_IN) { mt = 2; j = r / U_IN; r %= U_IN; }
            else if ((r -= 2 * U_IN) < 2 * U_O) { mt = 3; j = r / U_O; r %= U_O; }
            else if ((r -= 2 * U_O) < 4 * U_UP) { mt = 4; j = r / U_UP; r %= U_UP; }
            else { r -= 4 * U_UP; mt = 5; j = r / U_DN; r %= U_DN; }
            const int N = mt == 0 ? NQKV : mt == 2 ? NIN : mt == 4 ? NUP : DM, K = mt == 5 ? DFF : DM;
            const int nstrip = N / 256, kq = r / nstrip, strip = r % nstrip, nb = strip * 8 + wave;
            const int want = mt == 0 ? (2 * j) * 2 : mt == 2 ? (2 * j + 1) * 2 : mt == 4 ? j * 2 + 1 : -1;
            if (want >= 0 && want != cur_mat) {
                __syncthreads();
                const int l = want >> 1, chunk = (want & 1) ? 3 : 0;
                for (int k = tid; k < 2 * DM; k += NWAVES * 64) shv[k] = mod[(size_t)(l * 2 + (k >= DM ? 1 : 0)) * NADA + chunk * DM + (k & (DM - 1))];
                cur_mat = want;
                __syncthreads();
            }
            float bacc = 0.f;
            for (int kbi = 0; kbi < 8; ++kbi) {
                const int kb = kq * 8 + kbi;
                if (mt == 0) bacc += p0_transpose_item<false, true>(inptr(F, 6) + (size_t)j * DM * NQKV, DM, NQKV, (bf16*)(F.ws + WS_WQKV + j * SZ_WQKV), scr, kb, nb, lane, shv);
                else if (mt == 1) p0_transpose_item<false, false>(inptr(F, 7) + (size_t)j * DM * DM, DM, DM, (bf16*)(F.ws + WS_WO + j * SZ_WO), scr, kb, nb, lane);
                else if (mt == 2) bacc += p0_transpose_item<false, true>(inptr(F, 11) + (size_t)j * DM * NIN, DM, NIN, (bf16*)(F.ws + WS_WIN + j * SZ_WIN), scr, kb, nb, lane, shv);
                else if (mt == 3) p0_transpose_item<false, false>(inptr(F, 13) + (size_t)j * DM * DM, DM, DM, (bf16*)(F.ws + WS_WOUT + j * SZ_WO), scr, kb, nb, lane);
                else if (mt == 4) bacc += p0_transpose_item<true, true>(inptr(F, 14) + (size_t)j * DM * NUP, DM, NUP, (bf16*)(F.ws + WS_WUP + j * SZ_WUP), scr, kb, nb, lane, shv);
                else p0_transpose_item<false, false>(inptr(F, 17) + (size_t)j * DFF * DM, DFF, DM, (bf16*)(F.ws + WS_WDN + j * SZ_WDN), scr, kb, nb, lane);
            }
            if (want >= 0) {
                float* bp = mt == 4 ? bup + (size_t)j * (SZ_BUP / 4) : bg1 + (size_t)(mt == 0 ? 2 * j : 2 * j + 1) * (SZ_BG1 / 4);
                bp[(size_t)(kq * 2 + (lane >> 5)) * N + nb * 32 + (lane & 31)] = bacc;
            }
        }
    }
}

__device__ __forceinline__ void qkr_phase(Frame& F, int M, const float* qg, const float* kg) {
    PHASE_IDS;
    const int gw = F.vcu * NWAVES + wave, NGW = F.G * NWAVES;
    bf16* QKV = (bf16*)(F.ws + WS_QKV);
    const float2* rowtab = (const float2*)(F.ws + WS_ROPE); const float2* coltab = rowtab + 128 * 32;
    const int i = lane & 15, grp = lane >> 4;
    for (int m = gw; m < M; m += NGW) {
        const bool lat = m < SEQ;
        const int a = i >> 3, pos = a == 0 ? (m >> 6) : (m & 63);
        const float2* tab = (a == 0 ? rowtab : coltab) + pos * 32 + (i & 3) * 8;
        const bool second = (i & 4) != 0;
        v4u raws[5];
#pragma unroll
        for (int it = 0; it < 5; ++it) raws[it] = *(const v4u*)(QKV + (size_t)m * NQKV + (it * 4 + grp) * HDIM + 8 * i);
        asm volatile("" ::: "memory");
#pragma unroll
        for (int it = 0; it < 5; ++it) {
            const int head = it * 4 + grp;
            v4u* p = (v4u*)(QKV + (size_t)m * NQKV + head * HDIM + 8 * i);
            const v4u raw = raws[it];
            float x[8] = {bf_lo(raw.x), bf_hi(raw.x), bf_lo(raw.y), bf_hi(raw.y), bf_lo(raw.z), bf_hi(raw.z), bf_lo(raw.w), bf_hi(raw.w)};
            float ss = 0.f;
#pragma unroll
            for (int e = 0; e < 8; ++e) ss += x[e] * x[e];
            ss = row16_sum(ss);
            const float r = rsqrtf(ss * (1.f / HDIM) + RMS_EPS);
            const float* g = (head < NHQ ? qg : kg) + 8 * i;
#pragma unroll
            for (int e = 0; e < 8; ++e) x[e] = x[e] * r * g[e];
            if (lat) {
#pragma unroll
                for (int e = 0; e < 8; ++e) { const float part = swz_xor<0x101F>(x[e]);     const float2 cs = tab[e]; x[e] = second ? x[e] * cs.x + part * cs.y : x[e] * cs.x - part * cs.y; }
            }
            v4u w; w.x = pk2(x[0], x[1]); w.y = pk2(x[2], x[3]); w.z = pk2(x[4], x[5]); w.w = pk2(x[6], x[7]);
            *p = w;
        }
    }
}

__device__ __forceinline__ void unpack8(const v4u raw, float (&x)[8]) { x[0] = bf_lo(raw.x); x[1] = bf_hi(raw.x); x[2] = bf_lo(raw.y); x[3] = bf_hi(raw.y); x[4] = bf_lo(raw.z); x[5] = bf_hi(raw.z); x[6] = bf_lo(raw.w); x[7] = bf_hi(raw.w); }

__device__ __forceinline__ void glu_phase(Frame& F, int M, const float* cw, const float* cb) {
    PHASE_IDS;
    const int gw = F.vcu * NWAVES + wave, NGW = F.G * NWAVES;
    const bf16* GV = (const bf16*)(F.ws + WS_GV); bf16* U = (bf16*)(F.ws + WS_U);
    const int NU = (M / 16) * (DFF / 512);
    for (int u = gw; u < NU; u += NGW) {
        const int strip = u / (DFF / 512), ch = u % (DFF / 512), r0 = strip * 16, c0 = ch * 512 + lane * 8;
        float w0[8], w1[8], w2[8], bb[8];
#pragma unroll
        for (int e = 0; e < 8; ++e) { w0[e] = cw[c0 + e]; w1[e] = cw[DFF + c0 + e]; w2[e] = cw[2 * DFF + c0 + e]; bb[e] = cb[c0 + e]; }
        const bool hasp = (r0 != 0 && r0 != SEQ), hasn = (r0 + 16 != SEQ && r0 + 16 != M);
        float gp[8], gc[8], gn[8], vv[8];
        const bf16* gbase = GV + (size_t)r0 * NUP + c0;
        if (hasp) unpack8(*(const v4u*)(gbase - NUP), gp); else {
#pragma unroll
            for (int e = 0; e < 8; ++e) gp[e] = 0.f; }
        unpack8(*(const v4u*)gbase, gc);
#pragma unroll 4
        for (int r = 0; r < 16; ++r) {
            const bf16* grow = gbase + (size_t)r * NUP;
            if (r < 15 || hasn) unpack8(*(const v4u*)(grow + NUP), gn); else {
#pragma unroll
                for (int e = 0; e < 8; ++e) gn[e] = 0.f; }
            unpack8(*(const v4u*)(grow + DFF), vv);
            float o[8];
#pragma unroll
            for (int e = 0; e < 8; ++e) { const float t = w0[e] * gp[e] + w1[e] * gc[e] + w2[e] * gn[e] + bb[e]; o[e] = silu_f(t) * vv[e]; gp[e] = gc[e]; gc[e] = gn[e]; }
            v4u w; w.x = pk2(o[0], o[1]); w.y = pk2(o[2], o[3]); w.z = pk2(o[4], o[5]); w.w = pk2(o[6], o[7]);
            *(v4u*)(U + (size_t)(r0 + r) * DFF + c0) = w;
        }
    }
}

__device__ __forceinline__ void sc_phase(Frame& F, int M, const float* cw) {
    PHASE_IDS;
    const int gw = F.vcu * NWAVES + wave, NGW = F.G * NWAVES;
    const bf16* BCV = (const bf16*)(F.ws + WS_BCV); bf16* Z = (bf16*)(F.ws + WS_Z);
    const int NU = (M / 16) * (DM / 512);
    for (int u = gw; u < NU; u += NGW) {
        const int strip = u / (DM / 512), ch = u % (DM / 512), r0 = strip * 16, c0 = ch * 512 + lane * 8;
        float w0[8], w1[8], w2[8];
#pragma unroll
        for (int e = 0; e < 8; ++e) { w0[e] = cw[c0 + e]; w1[e] = cw[DM + c0 + e]; w2[e] = cw[2 * DM + c0 + e]; }
        const bool hasp = (r0 != 0 && r0 != SEQ), hasn = (r0 + 16 != SEQ && r0 + 16 != M);
        float zp[8], zc[8], zn[8], t0[8], t1[8];
        const bf16* base = BCV + (size_t)r0 * NIN + c0;
        if (hasp) { unpack8(*(const v4u*)(base - NIN + DM), t0); unpack8(*(const v4u*)(base - NIN + 2 * DM), t1);
#pragma unroll
            for (int e = 0; e < 8; ++e) zp[e] = t0[e] * t1[e]; } else {
#pragma unroll
            for (int e = 0; e < 8; ++e) zp[e] = 0.f; }
        unpack8(*(const v4u*)(base + DM), t0); unpack8(*(const v4u*)(base + 2 * DM), t1);
#pragma unroll
        for (int e = 0; e < 8; ++e) zc[e] = t0[e] * t1[e];
        for (int rb = 0; rb < 16; rb += 4) {
            v4u rc[4], rv[4], rbv[4];
#pragma unroll
            for (int q = 0; q < 4; ++q) { const bf16* row = base + (size_t)(rb + q) * NIN; rc[q] = *(const v4u*)(row + NIN + DM); rv[q] = *(const v4u*)(row + NIN + 2 * DM); rbv[q] = *(const v4u*)row; }
            asm volatile("" ::: "memory");
#pragma unroll
            for (int q = 0; q < 4; ++q) { const int r = rb + q;
                unpack8(rc[q], t0); unpack8(rv[q], t1);
                const bool has = (r < 15) || hasn;
#pragma unroll
                for (int e = 0; e < 8; ++e) zn[e] = has ? t0[e] * t1[e] : 0.f;
                unpack8(rbv[q], t0);
                float o[8];
#pragma unroll
                for (int e = 0; e < 8; ++e) { o[e] = t0[e] * (w0[e] * zp[e] + w1[e] * zc[e] + w2[e] * zn[e]); zp[e] = zc[e]; zc[e] = zn[e]; }
                v4u w; w.x = pk2(o[0], o[1]); w.y = pk2(o[2], o[3]); w.z = pk2(o[4], o[5]); w.w = pk2(o[6], o[7]);
                *(v4u*)(Z + (size_t)(r0 + r) * DM + c0) = w;
            }
        }
    }
}

typedef short cg_bf16x8 __attribute__((ext_vector_type(8)));
typedef float cg_f32x16 __attribute__((ext_vector_type(16)));
template <int MODE, int KW>
__device__ __forceinline__ void ctx_gemm(Frame& F, const bf16* A, const bf16* Bt, int N, const float* Xi, float* Xo, const float* gate, bf16* HNo, const float* scn, float* rowss, bf16* Oc, int ldo, const float* bias) {
    PHASE_IDS;
    const int r32 = lane & 31, hi = lane >> 5;
    constexpr int K = KW * NWAVES, kw = KW;
    const int ncb = N / 32, nitems = (CTXL / 32) * ncb;
    LAS float* part = (LAS float*)(F.lds + RING_OFF);
    for (int it = F.vcu; it < nitems; it += F.G) {
        const int cb = it / (CTXL / 32), rb = it % (CTXL / 32);
        const bf16* ap = A + (size_t)(rb * 32 + r32) * K + wave * kw + hi * 8;
        const bf16* bp = Bt + (size_t)(cb * 32 + r32) * K + wave * kw + hi * 8;
        cg_f32x16 acc = {0.f, 0.f, 0.f, 0.f, 0.f, 0.f, 0.f, 0.f, 0.f, 0.f, 0.f, 0.f, 0.f, 0.f, 0.f, 0.f};
        constexpr int CH = (KW == 256) ? 16 : 22;
        static_assert(KW % (16 * CH) == 0, "ctx_gemm: chunking");
#pragma unroll 1
        for (int k = 0; k < KW; k += 16 * CH) {
            cg_bf16x8 a[CH], b[CH];
#pragma unroll
            for (int q = 0; q < CH; ++q) { a[q] = *(const cg_bf16x8*)(ap + k + 16 * q); b[q] = *(const cg_bf16x8*)(bp + k + 16 * q); }
            __builtin_amdgcn_sched_barrier(0);
#pragma unroll
            for (int q = 0; q < CH; ++q) acc = __builtin_amdgcn_mfma_f32_32x32x16_bf16(a[q], b[q], acc, 0, 0, 0);
            __builtin_amdgcn_sched_barrier(0);
        }
#pragma unroll
        for (int r = 0; r < 16; ++r) part[(wave * 16 + r) * 64 + lane] = acc[r];
        __syncthreads();
#pragma unroll
        for (int h = 0; h < 2; ++h) {
            const int e = tid + h * (NWAVES * 64), r = e >> 6, ln = e & 63;
            float sum = 0.f;
#pragma unroll
            for (int w = 0; w < NWAVES; ++w) sum += part[(w * 16 + r) * 64 + ln];
            const int row = rb * 32 + (r & 3) + 8 * (r >> 2) + 4 * (ln >> 5), col = cb * 32 + (ln & 31);
            if (MODE == 0) {
                const float y = Xi[(size_t)row * DM + col] + gate[col] * sum; Xo[(size_t)row * DM + col] = y;
                if (HNo) { HNo[(size_t)row * DM + col] = (bf16)(pk2(y * (1.f + scn[col]), 0.f) & 0xffffu);
                    float ss = row16_sum(y * y); ss += swz_xor<0x401F>(ss);
                    if ((ln & 31) == 0) unsafeAtomicAdd(rowss + row, ss); }
            } else { const float rinv = __builtin_amdgcn_rsqf(pg8::ld_acc(rowss + row) * (1.f / DM) + RMS_EPS); const float bsum = (bias[(size_t)1 * N + col] + bias[(size_t)3 * N + col]) + (bias[(size_t)5 * N + col] + bias[(size_t)7 * N + col]);
                Oc[(size_t)row * ldo + col] = (bf16)(pk2(rinv * sum + bsum, 0.f) & 0xffffu); }
        }
        __syncthreads();
    }
}

__device__ __forceinline__ att::BlockRef<att::bf16, att::bf16> att_ref(int L, const att::bf16* QKV, att::bf16* AO, const float* sink) {
    att::BlockRef<att::bf16, att::bf16> r; int hq, row0;
    if (L < 512) { const int qb = L >> 4; hq = L & 15; row0 = qb * 256; r.jlo = qb == 0 ? 0 : 4 * qb - 2; const int jhi = (4 * qb + 6 > SEQ / 64) ? SEQ / 64 : 4 * qb + 6; r.ntb = jhi - r.jlo; }
    else { hq = L - 512; row0 = SEQ; r.jlo = 0; r.ntb = 0; }
    r.P0 = row0;
    r.Q = QKV + (size_t)row0 * NQKV + hq * HDIM; r.K = QKV + DM + (hq >> 2) * HDIM; r.V = QKV + DM + NHKV * HDIM + (hq >> 2) * HDIM; r.O = AO + (size_t)row0 * DM + hq * HDIM;
    r.m0 = sink[hq] * 11.313708498984761f;
    return r;
}
__device__ __forceinline__ void attn_phase(Frame& F, const float* sink, bool with_ctx) {
    const att::bf16* QKV = (const att::bf16*)(F.ws + WS_QKV); att::bf16* AO = (att::bf16*)(F.ws + WS_AO);
    const int NU = 512 + (with_ctx ? 16 : 0);
    int L = F.vcu; if (L >= NU) return;
    att::BlockRef<att::bf16, att::bf16> cur = att_ref(L, QKV, AO, sink);
    att::Seam<att::bf16> S;
    att::causal_swa_prime<att::bf16, att::bf16>(cur, F.ldsg + RING_OFF, S, F.wv);
    for (;;) {
        const bool more = L + F.G < NU; const int Ln = more ? L + F.G : L;
        const att::BlockRef<att::bf16, att::bf16> nxt = more ? att_ref(Ln, QKV, AO, sink) : cur;
        att::causal_swa_block<att::bf16, att::bf16>(cur, nxt, F.ldsg + RING_OFF, S, F.wv);
        if (!more) break;
        cur = nxt; L = Ln;
    }
}

#ifndef DUP_P0
#define DUP_P0 1
#endif
#ifndef DUP_N1
#define DUP_N1 1
#endif
#ifndef DUP_G1
#define DUP_G1 1
#endif
#ifndef DUP_SC
#define DUP_SC 1
#endif
#ifndef DUP_ATT
#define DUP_ATT 1
#endif
#ifndef DUP_N2
#define DUP_N2 1
#endif
#ifndef DUP_UP
#define DUP_UP 1
#endif
#ifndef DUP_GLU
#define DUP_GLU 1
#endif
struct Args { const float* in[18]; float* out; unsigned char* ws; int ph_lo, ph_hi; };
constexpr int N_PHASE_SLOTS = 2 + DEPTH * 6;
__global__ void __launch_bounds__(NWAVES * 64, 2) fwd_kernel(Args args) {
    extern __shared__ __attribute__((aligned(16))) unsigned char lds[];
    Frame F;
    F.lds = (LAS unsigned char*)lds; F.ldsg = (char*)lds;
    F.MISC = (volatile LAS unsigned*)(F.lds + MISC_OFF);
    F.G = gridDim.x; { const int bx = blockIdx.x; F.vcu = (F.G % 8 == 0) ? (bx % 8) * (F.G / 8) + bx / 8 : bx; }
    F.ws = args.ws; F.out = args.out;
    F.wv = __builtin_amdgcn_readfirstlane((int)threadIdx.x >> 6);
    for (int u = threadIdx.x; u < (LDS_BYTES - LDSCTL_OFF) / 4; u += NWAVES * 64) ((LAS unsigned*)(F.lds + LDSCTL_OFF))[u] = 0u;
    __syncthreads();
    if (threadIdx.x == 0) {
#pragma unroll
        for (int i = 0; i < 18; ++i) { const unsigned long long p = (unsigned long long)args.in[i]; LAS unsigned* t = (LAS unsigned*)(F.lds + LDSCTL_OFF + 64) + 2 * i; t[0] = (unsigned)p; t[1] = (unsigned)(p >> 32); }
    }
    __syncthreads();
    const int lo = args.ph_lo, hi = args.ph_hi;
    const bool single = (hi - lo) > 1;
    unsigned* barw = (unsigned*)(F.ws + WS_CTL) + CW_BAR;
    XcdBarrier bar; bar.bar = barw; bar.x = 0; bar.st = nullptr;
    if (single) bar = xcd_barrier_post(barw, F.MISC + 8, threadIdx.x == 0);
#define RUN(k) (lo <= (k) && (k) < hi)
#define GRID_BAR() do { if (single) xcd_barrier(bar, F.wv); } while (0)
    float* mod = (float*)(F.ws + WS_MOD);
    bf16* HN = (bf16*)(F.ws + WS_HN); float* XR = (float*)(F.ws + WS_XR);

    if (RUN(0)) { p0a_phase(F); GRID_BAR(); }
    if (RUN(1)) { for (int rep = 0; rep < DUP_P0; ++rep) { p0b_phase(F); __syncthreads(); } GRID_BAR(); }

    float* rowss_all = (float*)(F.ws + WS_CTL + CTL_ROWSS);
    for (int l = 0; l < DEPTH; ++l) {
        const int pb = 2 + l * 6, j = l >> 1; const bool attn = (l & 1) == 0;
        const bool ctx_g1 = l < 3;
        const bool ctx_on = l < 2;
        const float* mod_l = mod + (size_t)l * 2 * NADA;
        float* rowss_m = rowss_all + (size_t)(2 * l) * MR;
        float* rowss_f = rowss_all + (size_t)(2 * l + 1) * MR;
        if (RUN(pb + 0)) {
            const int N = attn ? NQKV : NIN;
            const bf16* Bt = attn ? (const bf16*)(F.ws + WS_WQKV + j * SZ_WQKV) : (const bf16*)(F.ws + WS_WIN + j * SZ_WIN);
            const float* bias = (const float*)(F.ws + WS_BG1 + (size_t)l * SZ_BG1);
            const int Mg = (attn && ctx_g1) ? MR : SEQ;
            if (!attn && ctx_g1 && ctx_on) ctx_gemm<1, DM / NWAVES>(F, HN + (size_t)HN_CTX0 * DM, Bt, N, nullptr, nullptr, nullptr, nullptr, nullptr, rowss_m + SEQ, (bf16*)(F.ws + WS_R1) + (size_t)SEQ * N, N, bias);
            pg8::Gemm g{HN, Bt, Mg, N, DM, HN_LAT0, 256, SEQ / 256, HN_CTX0}; pg8::StaticOrder S; S.init(Mg, N, F.G, (int)blockIdx.x);
            pg8::EpiBf16 E{(bf16*)(F.ws + WS_R1), N, rowss_m, bias, N, SEQ / 256, 1.f / DM, RMS_EPS};
            for (int rep = 0; rep < DUP_G1; ++rep) pg8::gemm_phase<pg8::EpiBf16, pg8::StaticOrder, true, true>(F.lds + RING_OFF, g, S, E, F.wv);
            GRID_BAR();
        }
        if (attn) {
            if (RUN(pb + 1)) { qkr_phase(F, ctx_g1 ? MR : SEQ, inptr(F, 8) + j * HDIM, inptr(F, 9) + j * HDIM); GRID_BAR(); }
            if (RUN(pb + 2)) { for (int rep = 0; rep < DUP_ATT; ++rep) attn_phase(F, inptr(F, 10) + j * NHQ, ctx_on); GRID_BAR(); }
        } else {
            if (RUN(pb + 1)) { for (int rep = 0; rep < DUP_SC; ++rep) sc_phase(F, ctx_on ? MR : SEQ, inptr(F, 12) + (size_t)j * 3 * DM); GRID_BAR(); }
        }
        if (RUN(pb + 3)) {
            const bf16* A = attn ? (const bf16*)(F.ws + WS_AO) : (const bf16*)(F.ws + WS_Z);
            const bf16* Bt = attn ? (const bf16*)(F.ws + WS_WO + j * SZ_WO) : (const bf16*)(F.ws + WS_WOUT + j * SZ_WO);
            const float* Xl = (l == 0) ? inptr(F, 0) : XR;
            const float* Xc = (l == 0) ? inptr(F, 2) : XR + (size_t)SEQ * DM;
            if (ctx_on) ctx_gemm<0, DM / NWAVES>(F, A + (size_t)SEQ * DM, Bt, DM, Xc, XR + (size_t)SEQ * DM, mod_l + NADA + 2 * DM, HN + (size_t)HN_CTX0 * DM, mod_l + NADA + 4 * DM, rowss_f + SEQ, nullptr, 0, nullptr);
            pg8::Gemm g{A, Bt, SEQ, DM, DM, 0, 256, 1 << 30, 0}; pg8::StaticOrder S; S.init(SEQ, DM, F.G, (int)blockIdx.x);
            pg8::EpiResid E{Xl, XR, DM, mod_l + 2 * DM, HN, mod_l + 4 * DM, rowss_f, HN_LAT0};
            pg8::gemm_phase<pg8::EpiResid, pg8::StaticOrder, true, true>(F.lds + RING_OFF, g, S, E, F.wv);
            GRID_BAR();
        }
        if (RUN(pb + 4)) {
            const int nM = (SEQ + 253) / 254 + (ctx_on ? 1 : 0);
            const float* bias = (const float*)(F.ws + WS_BUP + (size_t)l * SZ_BUP);
            pg8::Gemm g{HN, (const bf16*)(F.ws + WS_WUP + l * SZ_WUP), nM * 256, NUP, DM, 0, 254, (SEQ + 253) / 254, HN_CTX0}; pg8::StaticOrder S; S.init(nM * 256, NUP, F.G, (int)blockIdx.x);
            pg8::EpiGlu E{(bf16*)(F.ws + WS_U), DFF, inptr(F, 15) + (size_t)l * 3 * DFF, inptr(F, 16) + (size_t)l * DFF, DFF, (PG8_LAS pg8::f32x4*)(F.lds + XCH_OFF), (SEQ + 253) / 254, SEQ,
                          rowss_f, bias, NUP, 1.f / DM, RMS_EPS};
            for (int rep = 0; rep < DUP_UP; ++rep) pg8::gemm_phase<pg8::EpiGlu, pg8::StaticOrder, true, true>(F.lds + RING_OFF, g, S, E, F.wv);
            GRID_BAR();
        }
        if (RUN(pb + 5)) {
            const bool last = l == DEPTH - 1;
            const float* mod_n = mod_l + 2 * NADA;
            float* rowss_n = rowss_all + (size_t)(2 * l + 2 < 8 ? 2 * l + 2 : 0) * MR;
            if (ctx_on) ctx_gemm<0, DFF / NWAVES>(F, (const bf16*)(F.ws + WS_U) + (size_t)SEQ * DFF, (const bf16*)(F.ws + WS_WDN + l * SZ_WDN), DM, XR + (size_t)SEQ * DM, XR + (size_t)SEQ * DM, mod_l + NADA + 5 * DM,
                                                  HN + (size_t)HN_CTX0 * DM, mod_n + NADA + DM, rowss_n + SEQ, nullptr, 0, nullptr);
            pg8::Gemm g{(const bf16*)(F.ws + WS_U), (const bf16*)(F.ws + WS_WDN + l * SZ_WDN), SEQ, DM, DFF, 0, 256, 1 << 30, 0}; pg8::StaticOrder S; S.init(SEQ, DM, F.G, (int)blockIdx.x);
            pg8::EpiResid E{XR, last ? F.out : XR, DM, mod_l + 5 * DM, last ? (bf16*)nullptr : HN, last ? mod_l + DM : mod_n + DM, rowss_n, HN_LAT0};
            pg8::gemm_phase<pg8::EpiResid, pg8::StaticOrder, true, true>(F.lds + RING_OFF, g, S, E, F.wv);
            if (!last) GRID_BAR();
        }
    }
#undef RUN
#undef GRID_BAR
}

#ifndef MK_PER_PHASE
#define MK_PER_PHASE 0
#endif
extern "C" void kernel_launch(void* const* d_in, const int* in_sizes, int n_in, void* d_out, int out_size, void* d_ws, size_t ws_size, hipStream_t stream) {
    static int grid = 0;
    if (grid == 0) {
        if (n_in != 18 || in_sizes[0] != SEQ * DM || out_size != SEQ * DM || ws_size < WS_END) { fprintf(stderr, "kernel_launch: unexpected shapes (n_in %d, in0 %d, out %d, ws %zu < %zu?); nothing launched\n", n_in, n_in > 0 ? in_sizes[0] : -1, out_size, ws_size, (size_t)WS_END); grid = -1; return; }
        int dev = 0, cus = 0, per_cu = 0;
        if (hipGetDevice(&dev) != hipSuccess || hipDeviceGetAttribute(&cus, hipDeviceAttributeMultiprocessorCount, dev) != hipSuccess) { fprintf(stderr, "kernel_launch: device query failed\n"); grid = -1; return; }
        if (hipFuncSetAttribute((const void*)fwd_kernel, hipFuncAttributeMaxDynamicSharedMemorySize, LDS_BYTES) != hipSuccess) { fprintf(stderr, "kernel_launch: hipFuncSetAttribute failed\n"); grid = -1; return; }
        if (hipOccupancyMaxActiveBlocksPerMultiprocessor(&per_cu, (const void*)fwd_kernel, NWAVES * 64, LDS_BYTES) != hipSuccess || per_cu < 1)
            fprintf(stderr, "kernel_launch: note: occupancy query reports %d workgroups per CU\n", per_cu);
        (void)hipGetLastError();
        grid = cus;
    }
    if (grid < 0) return;
    if (hipMemsetAsync((char*)d_ws + WS_CTL, 0, CTL_ZERO_BYTES, stream) != hipSuccess) { fprintf(stderr, "kernel_launch: hipMemsetAsync failed\n"); return; }
    Args a{};
    for (int i = 0; i < 18; ++i) a.in[i] = (const float*)d_in[i];
    a.out = (float*)d_out; a.ws = (unsigned char*)d_ws;
#if MK_PER_PHASE
    for (int ph = 0; ph < N_PHASE_SLOTS; ++ph) {
        const int slot = ph < 2 ? -1 : (ph - 2) % 6, l = ph < 2 ? 0 : (ph - 2) / 6;
        if (slot == 2 && (l & 1)) continue;
        a.ph_lo = ph; a.ph_hi = ph + 1;
        hipLaunchKernelGGL(fwd_kernel, dim3(grid), dim3(NWAVES * 64), LDS_BYTES, stream, a);
    }
#else
    a.ph_lo = 0; a.ph_hi = N_PHASE_SLOTS;
    hipLaunchKernelGGL(fwd_kernel, dim3(grid), dim3(NWAVES * 64), LDS_BYTES, stream, a);
#endif
    const hipError_t le = hipPeekAtLastError();
    if (le != hipSuccess) fprintf(stderr, "kernel_launch: launch failed: %s\n", hipGetErrorName(le));
}
```
